# Optimizing an MI355X kernel written in HIP

```python
import math
import jax, jax.numpy as jnp
from jax import lax
import numpy as np

D_MODEL = 2048
BATCH = 4
SEQ = 2048
DEPTH = 4
DEC_BATCH = 128
DEC_SEQ = 1
PAST_LEN = 16384
PAGE_SIZE = 128

HGRN_HEADS = 8
HGRN_DK = 128
HGRN_DV = 128
HGRN_WIDTH = HGRN_HEADS * HGRN_DK
GLA_HEADS = 4
GLA_DK = 128
GLA_DV = 256
GLA_K_WIDTH = GLA_HEADS * GLA_DK
GLA_V_WIDTH = GLA_HEADS * GLA_DV
GLA_GATE_RANK = 16
GLA_GATE_NORM = 16.0
D_FF = 4 * D_MODEL
PLE_DIM = 256
CHUNK = 64
EPS = 1e-6

IN_WIDTHS = [HGRN_WIDTH, HGRN_WIDTH, HGRN_WIDTH, HGRN_WIDTH,
             GLA_K_WIDTH, GLA_K_WIDTH, GLA_V_WIDTH, GLA_V_WIDTH,
             GLA_GATE_RANK,
             D_MODEL, D_MODEL]
N_IN = sum(IN_WIDTHS)
IN_SPLITS = np.cumsum(IN_WIDTHS)[:-1].tolist()

kernel_name = "hgrn2_gla_gated_hybrid_step"


def _rmsnorm(x, g):
    xf = x.astype(jnp.float32)
    y = xf * lax.rsqrt(jnp.mean(xf * xf, axis=-1, keepdims=True) + EPS)
    return (y * g.astype(jnp.float32)).astype(x.dtype)


def _gated_recurrence(q, k, v, log_a, s0):
    B, L, H, K = q.shape
    V = v.shape[-1]
    c = math.gcd(CHUNK, L)
    n = L // c

    def to_blocks(t):
        return t.astype(jnp.float32).reshape(B, n, c, H, t.shape[-1]).transpose(1, 0, 3, 2, 4)

    qc, kc, vc, gc = to_blocks(q), to_blocks(k), to_blocks(v), to_blocks(log_a)
    causal = jnp.tril(jnp.ones((c, c), dtype=bool))[:, :, None]

    def step(s, inp):
        qi, ki, vi, gi = inp
        b = jnp.cumsum(gi, axis=-2)
        diff = b[..., :, None, :] - b[..., None, :, :]
        decay = jnp.exp(jnp.where(causal, diff, -jnp.inf))
        scores = jnp.einsum('bhtk,bhsk,bhtsk->bhts', qi, ki, decay)
        o = (jnp.einsum('bhts,bhsv->bhtv', scores, vi)
             + jnp.einsum('bhtk,bhkv->bhtv', qi * jnp.exp(b), s))
        b_last = b[..., -1:, :]
        s_new = (jnp.exp(b_last[..., 0, :])[..., None] * s
                 + jnp.einsum('bhsk,bhsv->bhkv', ki * jnp.exp(b_last - b), vi))
        return s_new, o

    s_fin, oc = lax.scan(step, s0.astype(jnp.float32), (qc, kc, vc, gc))
    o = oc.transpose(1, 0, 3, 2, 4).reshape(B, L, H, V)
    return o, s_fin


def _layer(h, p_i, s_h0, s_g0, lb_i, n_pre_mix, n_post_mix, n_pre_ffn, n_post_ffn,
           w_in, hgrn_norm, w_hgrn_up, w_gla_gate, b_gla_gate, gla_norm, w_gla_up,
           w_out, w_ff1, w_ff2, w_ple, w_ple_gate):
    B, L, _ = h.shape
    a = _rmsnorm(h, n_pre_mix)
    z = jnp.einsum('bld,dn->bln', a, w_in)
    (zq, zf, zi, zg, gq, gk, gv, gr, glr, m_h, m_g) = jnp.split(z, IN_SPLITS, axis=-1)

    lb = lb_i.reshape(HGRN_HEADS, HGRN_DK).astype(jnp.float32)
    fl = zf.reshape(B, L, HGRN_HEADS, HGRN_DK).astype(jnp.float32)
    log_f = jnp.logaddexp(jnp.log(lb), jnp.log1p(-lb) + jax.nn.log_sigmoid(fl))
    k_h = (1.0 - lb) * jax.nn.sigmoid(-fl)
    q_h = jax.nn.silu(zq).reshape(B, L, HGRN_HEADS, HGRN_DK)
    i_h = zi.reshape(B, L, HGRN_HEADS, HGRN_DV)
    o_h, s_h = _gated_recurrence(q_h, k_h, i_h, log_f, s_h0)
    o_h = _rmsnorm(o_h, hgrn_norm).astype(h.dtype) * jax.nn.silu(zg).reshape(B, L, HGRN_HEADS, HGRN_DV)
    y_h = jnp.einsum('blc,cd->bld', o_h.reshape(B, L, HGRN_WIDTH), w_hgrn_up)

    log_a = jax.nn.log_sigmoid((jnp.einsum('blr,rk->blk', glr, w_gla_gate) + b_gla_gate)
                               .astype(jnp.float32)) / GLA_GATE_NORM
    q_g = (gq * (GLA_DK ** -0.5)).reshape(B, L, GLA_HEADS, GLA_DK)
    k_g = gk.reshape(B, L, GLA_HEADS, GLA_DK)
    v_g = gv.reshape(B, L, GLA_HEADS, GLA_DV)
    o_g, s_g = _gated_recurrence(q_g, k_g, v_g, log_a.reshape(B, L, GLA_HEADS, GLA_DK), s_g0)
    o_g = _rmsnorm(o_g, gla_norm).astype(h.dtype) * jax.nn.silu(gr).reshape(B, L, GLA_HEADS, GLA_DV)
    y_g = jnp.einsum('blc,cd->bld', o_g.reshape(B, L, GLA_V_WIDTH), w_gla_up)

    merged = jax.nn.sigmoid(m_h) * y_h + jax.nn.sigmoid(m_g) * y_g
    h = h + _rmsnorm(jnp.einsum('bld,de->ble', merged, w_out), n_post_mix)

    c = _rmsnorm(h, n_pre_ffn)
    u = jnp.square(jax.nn.relu(jnp.einsum('bld,df->blf', c, w_ff1)))
    h = h + _rmsnorm(jnp.einsum('blf,fd->bld', u, w_ff2), n_post_ffn)

    pe = jnp.einsum('blp,pd->bld', p_i, w_ple)
    h = h + jax.nn.sigmoid(jnp.einsum('bld,de->ble', h, w_ple_gate)) * pe
    return h, s_h, s_g


def setup_inputs(seed: int = 0) -> dict:
    key = jax.random.key(seed)
    ks = jax.random.split(key, 24)
    f32 = jnp.float32
    nrm = lambda k, shape, scale: jax.random.normal(k, shape, f32) * scale
    gain = lambda k, shape: 1.0 + 0.05 * jax.random.normal(k, shape, f32)
    return {
        "x_prompt": nrm(ks[0], (BATCH, SEQ, D_MODEL), 1.0),
        "x_sample": nrm(ks[1], (DEC_BATCH, DEC_SEQ, D_MODEL), 1.0),
        "p_prompt": nrm(ks[2], (DEPTH, BATCH, SEQ, PLE_DIM), 1.0),
        "p_sample": nrm(ks[3], (DEPTH, DEC_BATCH, DEC_SEQ, PLE_DIM), 1.0),
        "state_hgrn": nrm(ks[4], (DEPTH, DEC_BATCH, HGRN_HEADS, HGRN_DK, HGRN_DV), 0.5),
        "state_gla": nrm(ks[5], (DEPTH, DEC_BATCH, GLA_HEADS, GLA_DK, GLA_DV), 0.5),
        "norm_pre_mix": gain(ks[6], (DEPTH, D_MODEL)),
        "norm_post_mix": gain(ks[7], (DEPTH, D_MODEL)),
        "norm_pre_ffn": gain(ks[8], (DEPTH, D_MODEL)),
        "norm_post_ffn": gain(ks[9], (DEPTH, D_MODEL)),
        "w_in": nrm(ks[10], (DEPTH, D_MODEL, N_IN), D_MODEL ** -0.5),
        "lb_param": nrm(ks[11], (DEPTH, HGRN_WIDTH), 0.1),
        "hgrn_norm": gain(ks[12], (DEPTH, HGRN_DV)),
        "w_hgrn_up": nrm(ks[13], (DEPTH, HGRN_WIDTH, D_MODEL), HGRN_WIDTH ** -0.5),
        "w_gla_gate": nrm(ks[14], (DEPTH, GLA_GATE_RANK, GLA_K_WIDTH), GLA_GATE_RANK ** -0.5),
        "b_gla_gate": nrm(ks[15], (DEPTH, GLA_K_WIDTH), 0.1),
        "gla_norm": gain(ks[16], (DEPTH, GLA_DV)),
        "w_gla_up": nrm(ks[17], (DEPTH, GLA_V_WIDTH, D_MODEL), GLA_V_WIDTH ** -0.5),
        "w_out": nrm(ks[18], (DEPTH, D_MODEL, D_MODEL), D_MODEL ** -0.5),
        "w_ff1": nrm(ks[19], (DEPTH, D_MODEL, D_FF), D_MODEL ** -0.5),
        "w_ff2": nrm(ks[20], (DEPTH, D_FF, D_MODEL), D_FF ** -0.5),
        "w_ple": nrm(ks[21], (DEPTH, PLE_DIM, D_MODEL), PLE_DIM ** -0.5),
        "w_ple_gate": nrm(ks[22], (DEPTH, D_MODEL, D_MODEL), D_MODEL ** -0.5),
    }


def reference(x_prompt, x_sample, p_prompt, p_sample, state_hgrn, state_gla,
              norm_pre_mix, norm_post_mix, norm_pre_ffn, norm_post_ffn, w_in, lb_param,
              hgrn_norm, w_hgrn_up, w_gla_gate, b_gla_gate, gla_norm, w_gla_up, w_out,
              w_ff1, w_ff2, w_ple, w_ple_gate):
    lbs = jnp.cumsum(jax.nn.softmax(lb_param.astype(jnp.float32), axis=0), axis=0)
    lbs = lbs - lbs[0:1]
    Bp = x_prompt.shape[0]
    hp, hs = x_prompt, x_sample
    hgrn_p, gla_p, hgrn_s, gla_s = [], [], [], []
    for i in range(DEPTH):
        w_i = (lbs[i], norm_pre_mix[i], norm_post_mix[i], norm_pre_ffn[i], norm_post_ffn[i],
               w_in[i], hgrn_norm[i], w_hgrn_up[i], w_gla_gate[i], b_gla_gate[i], gla_norm[i],
               w_gla_up[i], w_out[i], w_ff1[i], w_ff2[i], w_ple[i], w_ple_gate[i])
        zh = jnp.zeros((Bp, HGRN_HEADS, HGRN_DK, HGRN_DV), jnp.float32)
        zg = jnp.zeros((Bp, GLA_HEADS, GLA_DK, GLA_DV), jnp.float32)
        hp, sh, sg = _layer(hp, p_prompt[i], zh, zg, *w_i)
        hgrn_p.append(sh.astype(state_hgrn.dtype))
        gla_p.append(sg.astype(state_gla.dtype))
        hs, sh, sg = _layer(hs, p_sample[i], state_hgrn[i], state_gla[i], *w_i)
        hgrn_s.append(sh.astype(state_hgrn.dtype))
        gla_s.append(sg.astype(state_gla.dtype))
    return (hp, hs, jnp.stack(hgrn_p), jnp.stack(gla_p), jnp.stack(hgrn_s), jnp.stack(gla_s))
```

```cpp
#include <hip/hip_runtime.h>
#include <cstdio>
#include <cstdint>

__device__ __forceinline__ int tidx() { int t = threadIdx.x; asm volatile("" : "+v"(t)); return t; }

namespace pg8 {
#define PG8_LAS __attribute__((address_space(3)))
typedef unsigned short bf16_t;
typedef short bf16x8 __attribute__((ext_vector_type(8)));
typedef float f32x4 __attribute__((ext_vector_type(4)));
typedef unsigned u32x4 __attribute__((ext_vector_type(4)));
constexpr int BM = 256, BK = 64, HALF = 128, HTB = HALF * BK * 2, STAGE_BYTES = 8 * HTB, NXCD = 8, WGM = 8;

__host__ __device__ __forceinline__ int lds_byte(int r, int c) { const int st = (r >> 4) * 2 + (c >> 5), rr = r & 15, cc = c & 31, ob = rr * 64 + cc * 2; return st * 1024 + (ob ^ (((ob >> 9) & 1) << 5)); }
__host__ __device__ __forceinline__ void stage_rc(int b, int& R, int& C) { const int st = b / 1024, sb = b % 1024, swz = sb ^ (((sb >> 9) & 1) << 5); R = (st >> 1) * 16 + swz / 64; C = (st & 1) * 32 + (swz % 64) / 2; }
__host__ __device__ __forceinline__ int perm32(int rho) { const int n = rho >> 4, i = rho & 15; return 8 * (i >> 2) + 4 * n + (i & 3); }

struct Unit { int pm, pn; };
struct Gemm { const bf16_t* A; const bf16_t* Bt; int M, N, K, lda, ldb; };

struct StaticOrder {
    int nM, nN, nwg, G, c;
    __host__ __device__ __forceinline__ void init(int M, int N, int G_, int c_) { nM = M / BM; nN = N / BM; nwg = nM * nN; G = G_; c = c_; }
    __host__ __device__ __forceinline__ bool next(int i, Unit& u) const {
        const long L = (long)i * G + c; if (L >= nwg) return false;
        int wgid = (int)L; { const int q = nwg / NXCD, r = nwg % NXCD, xcd = wgid % NXCD, off = wgid / NXCD; wgid = (xcd < r ? xcd * (q + 1) : r * (q + 1) + (xcd - r) * q) + off; }
        const int nig = WGM * nN, gid = wgid / nig, fm = gid * WGM, gsz = (nM - fm) < WGM ? (nM - fm) : WGM;
        u.pm = fm + ((wgid % nig) % gsz); u.pn = (wgid % nig) / gsz; return true;
    }
    __device__ __forceinline__ void a_ready(const Unit&) const {}
    __device__ __forceinline__ void done(const Unit&) const {}
};

typedef float f32x2_t __attribute__((ext_vector_type(2)));
typedef __bf16 bf16x2_t __attribute__((ext_vector_type(2)));
__device__ __forceinline__ unsigned cvt_pk_bf16(float lo, float hi) { return __builtin_bit_cast(unsigned, __builtin_convertvector((f32x2_t){lo, hi}, bf16x2_t)); }

template <class Epi, class Sched, bool ALIGN_EPI = false, bool SP2 = false>
__device__ __forceinline__ void gemm_phase(PG8_LAS unsigned char* lds, const Gemm g, const Sched& S, const Epi& E) {
    const int tid = tidx();
    const int wid = __builtin_amdgcn_readfirstlane(tid >> 6), lane = tid & 63, wr = wid >> 2, wc = wid & 3, fr = lane & 15, fq = lane >> 4;
    const int K = g.K, nt = K / BK;
    unsigned voffA[2], voffB[2];
#pragma unroll
    for (int i = 0; i < 2; ++i) { int R, C; stage_rc(tid * 16 + i * 8192, R, C); const int Rb = Epi::PERM ? ((R & ~31) + perm32(R & 31)) : R;
        voffA[i] = (unsigned)(R * g.lda + C) * 2u; voffB[i] = (unsigned)(Rb * g.ldb + C) * 2u; }
    const size_t kstep = (size_t)(BK * 2);
    const size_t hstepA = (size_t)HALF * g.lda * 2, hstepB = (size_t)HALF * g.ldb * 2;
    const size_t tstepA = 2 * hstepA, tstepB = 2 * hstepB;
    const unsigned ldsw = (unsigned)wid * 1024u;
    const int aoff = lds_byte(wr * 64 + fr, fq * 8), boff = lds_byte(wc * 32 + fr, fq * 8);
#define PG8_SA(b, h) (((b) * 2 + (h)) * HTB)
#define PG8_SB(b, h) ((4 + (b) * 2 + (h)) * HTB)
#define PG8_STAGE(bufoff, gbase, voff) do { _Pragma("unroll") for (int _i = 0; _i < 2; ++_i) \
        __builtin_amdgcn_global_load_lds((const unsigned*)((const char*)(gbase) + (voff)[_i]), (PG8_LAS unsigned*)(lds + (bufoff) + ldsw + _i * 8192), 16, 0, 0); } while (0)
#define PG8_LDA(dst, b, h) do { _Pragma("unroll") for (int m = 0; m < 4; ++m) _Pragma("unroll") for (int k = 0; k < 2; ++k) dst[m][k] = *(const PG8_LAS bf16x8*)(lds + PG8_SA(b, h) + aoff + m * 2048 + k * 1024); } while (0)
#define PG8_LDB(dst, b, h) do { _Pragma("unroll") for (int n = 0; n < 2; ++n) _Pragma("unroll") for (int k = 0; k < 2; ++k) dst[n][k] = *(const PG8_LAS bf16x8*)(lds + PG8_SB(b, h) + boff + n * 2048 + k * 1024); } while (0)
#define PG8_MMA(ai, bj, At, Bt) do { __builtin_amdgcn_s_setprio(1); _Pragma("unroll") for (int m = 0; m < 4; ++m) _Pragma("unroll") for (int n = 0; n < 2; ++n) _Pragma("unroll") for (int k = 0; k < 2; ++k) \
        acc[ai][bj][m][n] = __builtin_amdgcn_mfma_f32_16x16x32_bf16(Bt[n][k], At[m][k], acc[ai][bj][m][n], 0, 0, 0); __builtin_amdgcn_s_setprio(0); } while (0)
#define PG8_WAIT_V(n) asm volatile("s_waitcnt vmcnt(" #n ")" ::: "memory")
#define PG8_WAIT_L(n) asm volatile("s_waitcnt lgkmcnt(" #n ")" ::: "memory")
#define PG8_BAR __builtin_amdgcn_s_barrier()
#define PG8_SCHED __builtin_amdgcn_sched_barrier(0)
    Unit cur, nxt; int ui = 0;
    if (!S.next(0, cur)) return;
    f32x4 acc[2][2][4][2];
#pragma unroll
    for (int a = 0; a < 2; ++a)
#pragma unroll
        for (int b = 0; b < 2; ++b)
#pragma unroll
            for (int m = 0; m < 4; ++m)
#pragma unroll
                for (int n = 0; n < 2; ++n) acc[a][b][m][n] = (f32x4){0.f, 0.f, 0.f, 0.f};
    bf16x8 At[4][2], B0[2][2], B1[2][2];
    const char* cA = (const char*)g.A + (size_t)cur.pm * tstepA; const char* cB = (const char*)g.Bt + (size_t)cur.pn * tstepB;
    S.a_ready(cur);
    if constexpr (SP2) {
        PG8_STAGE(PG8_SB(0, 0), cB, voffB); PG8_STAGE(PG8_SB(0, 1), cB + hstepB, voffB); PG8_STAGE(PG8_SA(0, 0), cA, voffA); PG8_STAGE(PG8_SA(0, 1), cA + hstepA, voffA);
        if (wr == 1) PG8_BAR;
        PG8_WAIT_V(2); PG8_BAR;
        PG8_STAGE(PG8_SB(1, 0), cB + kstep, voffB); PG8_STAGE(PG8_SA(1, 0), cA + kstep, voffA); PG8_STAGE(PG8_SB(1, 1), cB + hstepB + kstep, voffB);
        PG8_WAIT_V(6); PG8_BAR;
    } else {
        PG8_STAGE(PG8_SB(0, 0), cB, voffB); PG8_STAGE(PG8_SA(0, 0), cA, voffA); PG8_STAGE(PG8_SB(0, 1), cB + hstepB, voffB); PG8_STAGE(PG8_SA(0, 1), cA + hstepA, voffA);
        if (wr == 1) PG8_BAR;
        PG8_WAIT_V(4); PG8_BAR;
        PG8_STAGE(PG8_SB(1, 0), cB + kstep, voffB); PG8_STAGE(PG8_SA(1, 0), cA + kstep, voffA); PG8_STAGE(PG8_SB(1, 1), cB + hstepB + kstep, voffB);
        PG8_WAIT_V(6); PG8_BAR;
    }
    for (;;) {
        const bool has_next = S.next(ui + 1, nxt);
        const char* nA = has_next ? (const char*)g.A + (size_t)nxt.pm * tstepA : cA; const char* nB = has_next ? (const char*)g.Bt + (size_t)nxt.pn * tstepB : cB;
        for (int t = 0; t < nt; t += 2) {
            const bool last = (t == nt - 2);
            const char* a1 = cA + (size_t)(t + 1) * kstep;
            const char* a2 = last ? nA : cA + (size_t)(t + 2) * kstep; const char* b2 = last ? nB : cB + (size_t)(t + 2) * kstep;
            const char* a3 = a2 + kstep; const char* b3 = b2 + kstep;
            if (last && has_next) S.a_ready(nxt);
            if constexpr (SP2) {
            PG8_LDB(B0, 0, 0); PG8_LDB(B1, 0, 1); PG8_SCHED; PG8_LDA(At, 0, 0); PG8_STAGE(PG8_SA(1, 1), a1 + hstepA, voffA);
            PG8_WAIT_V(8); PG8_WAIT_L(0); PG8_BAR; PG8_MMA(0, 0, At, B0); PG8_MMA(0, 1, At, B1); PG8_BAR; PG8_SCHED;
            PG8_LDA(At, 0, 1); PG8_STAGE(PG8_SB(0, 0), b2, voffB); PG8_STAGE(PG8_SB(0, 1), b2 + hstepB, voffB); PG8_STAGE(PG8_SA(0, 0), a2, voffA);
            PG8_WAIT_V(8); PG8_WAIT_L(0); PG8_BAR; PG8_MMA(1, 0, At, B0); PG8_MMA(1, 1, At, B1); PG8_BAR; PG8_SCHED;
            PG8_LDB(B0, 1, 0); PG8_LDB(B1, 1, 1); PG8_SCHED; PG8_LDA(At, 1, 0); PG8_STAGE(PG8_SA(0, 1), a2 + hstepA, voffA);
            PG8_WAIT_V(8); PG8_WAIT_L(0); PG8_BAR; PG8_MMA(0, 0, At, B0); PG8_MMA(0, 1, At, B1); PG8_BAR; PG8_SCHED;
            PG8_LDA(At, 1, 1); PG8_STAGE(PG8_SB(1, 0), b3, voffB); PG8_STAGE(PG8_SB(1, 1), b3 + hstepB, voffB); PG8_STAGE(PG8_SA(1, 0), a3, voffA);
            PG8_WAIT_V(8); PG8_WAIT_L(0); PG8_BAR; PG8_MMA(1, 0, At, B0); PG8_MMA(1, 1, At, B1); PG8_BAR; PG8_SCHED;
            } else {
            PG8_LDB(B0, 0, 0); PG8_SCHED; PG8_LDA(At, 0, 0); PG8_STAGE(PG8_SA(1, 1), a1 + hstepA, voffA);
            PG8_WAIT_L(8); PG8_BAR; PG8_WAIT_L(0); PG8_MMA(0, 0, At, B0); PG8_BAR; PG8_SCHED;
            PG8_LDB(B1, 0, 1); PG8_STAGE(PG8_SB(0, 0), b2, voffB);
            PG8_BAR; PG8_WAIT_L(0); PG8_MMA(0, 1, At, B1); PG8_BAR;
            PG8_LDA(At, 0, 1); PG8_STAGE(PG8_SA(0, 0), a2, voffA);
            PG8_BAR; PG8_WAIT_L(0); PG8_MMA(1, 0, At, B0); PG8_BAR; PG8_SCHED;
            PG8_STAGE(PG8_SB(0, 1), b2 + hstepB, voffB);
            PG8_WAIT_V(6); PG8_BAR; PG8_MMA(1, 1, At, B1); PG8_BAR;
            PG8_LDB(B0, 1, 0); PG8_SCHED; PG8_LDA(At, 1, 0); PG8_STAGE(PG8_SA(0, 1), a2 + hstepA, voffA);
            PG8_WAIT_L(8); PG8_BAR; PG8_WAIT_L(0); PG8_MMA(0, 0, At, B0); PG8_BAR; PG8_SCHED;
            PG8_LDB(B1, 1, 1); PG8_STAGE(PG8_SB(1, 0), b3, voffB);
            PG8_BAR; PG8_WAIT_L(0); PG8_MMA(0, 1, At, B1); PG8_BAR;
            PG8_LDA(At, 1, 1); PG8_STAGE(PG8_SA(1, 0), a3, voffA);
            PG8_BAR; PG8_WAIT_L(0); PG8_MMA(1, 0, At, B0); PG8_BAR; PG8_SCHED;
            PG8_STAGE(PG8_SB(1, 1), b3 + hstepB, voffB);
            PG8_WAIT_V(6); PG8_BAR; PG8_MMA(1, 1, At, B1); PG8_BAR;
            }
        }
        if constexpr (ALIGN_EPI) { if (wr == 0) PG8_BAR; }
        if constexpr (!Epi::AFTER_DRAIN) { E(acc, cur, wr, wc, fr, fq); S.done(cur); }
        if (!has_next) break;
#pragma unroll
        for (int a = 0; a < 2; ++a)
#pragma unroll
            for (int b = 0; b < 2; ++b)
#pragma unroll
                for (int m = 0; m < 4; ++m)
#pragma unroll
                    for (int n = 0; n < 2; ++n) acc[a][b][m][n] = (f32x4){0.f, 0.f, 0.f, 0.f};
        cur = nxt; cA = nA; cB = nB; ++ui;
        if constexpr (ALIGN_EPI) { if (wr == 1) PG8_BAR; }
    }
    PG8_WAIT_V(0);
    if constexpr (!ALIGN_EPI) { if (wr == 0) PG8_BAR; }
    PG8_BAR;
    if constexpr (Epi::AFTER_DRAIN) { E.fused(acc, cur, wr, wc, fr, fq, lds, wid, lane); S.done(cur); }
#undef PG8_SA
#undef PG8_SB
#undef PG8_STAGE
#undef PG8_LDA
#undef PG8_LDB
#undef PG8_MMA
#undef PG8_WAIT_V
#undef PG8_WAIT_L
#undef PG8_BAR
#undef PG8_SCHED
}
}

#define LAS __attribute__((address_space(3)))
typedef unsigned short bf16_t;
typedef float f32x4 __attribute__((ext_vector_type(4)));
typedef unsigned u32x4 __attribute__((ext_vector_type(4)));
typedef unsigned u32x2 __attribute__((ext_vector_type(2)));

constexpr int NWAVES = 8, NTHR = 512;
constexpr int D = 2048, BATCH = 4, SEQ = 2048, DEPTH = 4, DECB = 128;
constexpr int MP = BATCH * SEQ;
constexpr int MT = MP + DECB;
constexpr int MR = 8448;
constexpr int HH = 8, HK = 128, HV = 128, HW = 1024;
constexpr int GH = 4, GK = 128, GV = 256, GKW = 512, GVW = 1024, GR = 16;
constexpr int DFF = 8192, PLE = 256;
constexpr int NIN = 11280;
constexpr int NZ = 11776;
constexpr int C_GLR = 7168;
constexpr float EPS = 1e-6f;
constexpr int SSQW = 64;

constexpr size_t al256(size_t x) { return (x + 255) & ~(size_t)255; }
constexpr size_t WS_CTL = 0, CTL_BYTES = 1u << 20;
constexpr int CW_X6CNT = 8192, CW_X4CNT = 16384, CW_X6 = 32768, CW_X4 = 98304, CW_SSQ2 = 163840;
static_assert(CW_X6CNT + DEPTH * 32 * 64 <= CW_X4CNT && CW_X4CNT + DEPTH * 32 * 64 <= CW_X6 && CW_X6 + MP * 8 <= CW_X4 && CW_X4 + MP * 8 <= CW_SSQ2 && (size_t)(CW_SSQ2 + MR * 8) * 4 <= CTL_BYTES, "CTL sub-regions");
constexpr size_t WS_LBS = WS_CTL + CTL_BYTES;
constexpr size_t WS_SSQ = WS_LBS + al256(4 * 1024 * 4);
constexpr size_t WS_WIN = WS_SSQ + al256((size_t)MR * SSQW * 4);
constexpr size_t WS_WUH = WS_WIN + (size_t)DEPTH * NZ * D * 2;
constexpr size_t WS_WUG = WS_WUH + (size_t)DEPTH * D * HW * 2;
constexpr size_t WS_WOUT = WS_WUG + (size_t)DEPTH * D * GVW * 2;
constexpr size_t WS_WFF1 = WS_WOUT + (size_t)DEPTH * D * D * 2;
constexpr size_t WS_WFF2 = WS_WFF1 + (size_t)DEPTH * DFF * D * 2;
constexpr size_t WS_WPLE = WS_WFF2 + (size_t)DEPTH * D * DFF * 2;
constexpr size_t WS_WPLG = WS_WPLE + (size_t)DEPTH * D * PLE * 2;
constexpr size_t WS_H32 = WS_WPLG + (size_t)DEPTH * D * D * 2;
constexpr size_t WS_HBF3 = WS_H32;
constexpr size_t WS_HBF = WS_H32 + (size_t)MR * D * 4;
constexpr size_t WS_QH = WS_HBF + (size_t)MR * D * 2;
constexpr size_t WS_KH = WS_QH + (size_t)MR * HW * 2;
constexpr size_t WS_VH = WS_KH + (size_t)MR * HW * 2;
constexpr size_t WS_GHG = WS_VH + (size_t)MR * HW * 2;
constexpr size_t WS_LOGF = WS_GHG + (size_t)MR * HW * 2;
constexpr size_t WS_QG = WS_LOGF + (size_t)MR * HW * 4;
constexpr size_t WS_KG = WS_QG + (size_t)MR * GKW * 2;
constexpr size_t WS_VG = WS_KG + (size_t)MR * GKW * 2;
constexpr size_t WS_RG = WS_VG + (size_t)MR * GVW * 2;
constexpr size_t WS_LOGA = WS_RG + (size_t)MR * GVW * 2;
constexpr size_t WS_MH = WS_LOGA + (size_t)MR * GKW * 4;
constexpr size_t WS_MG = WS_MH + (size_t)MR * D * 2;
constexpr size_t WS_T32 = WS_MG + (size_t)MR * D * 2;
constexpr size_t WS_OG = WS_T32 + (size_t)MR * D * 4;
constexpr size_t WS_MRG = WS_OG + (size_t)MR * D * 2;
constexpr size_t WS_U = WS_MRG + (size_t)MR * D * 2;
constexpr size_t WS_PE = WS_U + (size_t)MR * DFF * 2;
constexpr size_t WS_HBF2 = WS_PE + (size_t)DEPTH * MR * D * 2;
constexpr size_t WS_PBF = WS_HBF2 + (size_t)MR * D * 2;
constexpr size_t WS_PART = WS_PBF + (size_t)DEPTH * MT * PLE * 2;
constexpr size_t WS_H32B = WS_PART + (size_t)12 * DECB * D * 4;
constexpr size_t WS_H32C = WS_H32B + (size_t)MR * D * 4;
constexpr size_t WS_END = WS_H32C + (size_t)MR * D * 4;

constexpr int LDS_BYTES = 147456;

struct P {
    const float *xp, *xs, *pp, *ps, *sth, *stg, *n_pre_mix, *n_post_mix, *n_pre_ffn, *n_post_ffn, *w_in, *lbp, *hgn, *w_hup, *wgg, *bgg, *gln, *w_gup, *w_out, *w_ff1, *w_ff2, *w_ple, *w_plg;
    float* out; unsigned char* ws;
};

__device__ __forceinline__ float bf2f(bf16_t b) { return __uint_as_float(((unsigned)b) << 16); }
__device__ __forceinline__ unsigned pk2(float lo, float hi) { return pg8::cvt_pk_bf16(lo, hi); }
__device__ __forceinline__ void unpack8(const u32x4 w, float (&v)[8]) {
    v[0] = __uint_as_float(w.x << 16); v[1] = __uint_as_float(w.x & 0xffff0000u); v[2] = __uint_as_float(w.y << 16); v[3] = __uint_as_float(w.y & 0xffff0000u);
    v[4] = __uint_as_float(w.z << 16); v[5] = __uint_as_float(w.z & 0xffff0000u); v[6] = __uint_as_float(w.w << 16); v[7] = __uint_as_float(w.w & 0xffff0000u);
}
__device__ __forceinline__ u32x4 pack8(const float (&v)[8]) { u32x4 w; w.x = pk2(v[0], v[1]); w.y = pk2(v[2], v[3]); w.z = pk2(v[4], v[5]); w.w = pk2(v[6], v[7]); return w; }
__device__ __forceinline__ float clampf(float x, float lo, float hi) { return __builtin_amdgcn_fmed3f(x, lo, hi); }
__device__ __forceinline__ float sigm(float x) { return __builtin_amdgcn_rcpf(1.f + __builtin_amdgcn_exp2f(x * -1.4426950408889634f)); }
__device__ __forceinline__ float silu(float x) { return x * sigm(x); }
__device__ __forceinline__ float wave_sum(float v) {
#pragma unroll
    for (int o = 1; o < 64; o <<= 1) v += __shfl_xor(v, o);
    return v;
}

struct FIn {
    const float* ssq; const float* lbs; const float* bgg; unsigned char* wsb;
    const LAS float* rst; int pm0, pm1, pm2;
    __device__ __forceinline__ float rowctx(int row) const {
        const int pm = row >> 8, rl = row & 255;
        if (pm == pm0) return rst[rl];
        if (pm == pm1) return rst[256 + rl];
        if (pm == pm2) return rst[512 + rl];
        float sc = 0.f; const int np = row >= MP ? SSQW : 8;
#pragma nounroll
        for (int i = 0; i < np; ++i) sc += ssq[(size_t)row * SSQW + i];
        return rsqrtf(sc * (1.f / D) + EPS);
    }
    __device__ __forceinline__ float rowctx_g(int row) const {
        const f32x4* p = (const f32x4*)(ssq + (size_t)row * SSQW); float s = 0.f;
        { const f32x4 x = p[0], y = p[1]; s = ((x[0] + x[1]) + (x[2] + x[3])) + ((y[0] + y[1]) + (y[2] + y[3])); }
        if (row >= MP) {
#pragma unroll
            for (int i = 2; i < SSQW / 4; ++i) { const f32x4 x = p[i]; s += (x[0] + x[1]) + (x[2] + x[3]); } }
        return rsqrtf(s * (1.f / D) + EPS);
    }
    __device__ __forceinline__ void apply8(int row, int col, const float (&a)[8], float rs) const {
        float v[8];
#pragma unroll
        for (int j = 0; j < 8; ++j) v[j] = a[j] * rs;
        const float rsn = rs * -1.4426950408889634f;
        if (col < 1024) {
#pragma unroll
            for (int j = 0; j < 8; ++j) v[j] = v[j] * __builtin_amdgcn_rcpf(1.f + __builtin_amdgcn_exp2f(a[j] * rsn));
            *(u32x4*)((bf16_t*)(wsb + WS_QH) + (size_t)row * HW + col) = pack8(v);
        } else if (col < 2048) {
            const int c = col - 1024; float lg[8], kk[8];
            const f32x4 l0 = *(const f32x4*)(lbs + c), l1 = *(const f32x4*)(lbs + c + 4);
#pragma unroll
            for (int j = 0; j < 8; ++j) { const float lb = j < 4 ? l0[j] : l1[j - 4]; const float e = __expf(-clampf(v[j], -30.f, 30.f)); const float sg = __builtin_amdgcn_rcpf(1.f + e);
                lg[j] = __builtin_amdgcn_logf(lb + (1.f - lb) * sg) * 0.6931471805599453f; kk[j] = (1.f - lb) * e * sg; }
            *(f32x4*)((float*)(wsb + WS_LOGF) + (size_t)row * HW + c) = (f32x4){lg[0], lg[1], lg[2], lg[3]}; *(f32x4*)((float*)(wsb + WS_LOGF) + (size_t)row * HW + c + 4) = (f32x4){lg[4], lg[5], lg[6], lg[7]};
            *(u32x4*)((bf16_t*)(wsb + WS_KH) + (size_t)row * HW + c) = pack8(kk);
        } else if (col < 3072) {
            *(u32x4*)((bf16_t*)(wsb + WS_VH) + (size_t)row * HW + (col - 2048)) = pack8(v);
        } else if (col < 4096) {
#pragma unroll
            for (int j = 0; j < 8; ++j) v[j] = v[j] * __builtin_amdgcn_rcpf(1.f + __builtin_amdgcn_exp2f(a[j] * rsn));
            *(u32x4*)((bf16_t*)(wsb + WS_GHG) + (size_t)row * HW + (col - 3072)) = pack8(v);
        } else if (col < 4608) {
            *(u32x4*)((bf16_t*)(wsb + WS_QG) + (size_t)row * GKW + (col - 4096)) = pack8(v);
        } else if (col < 5120) {
            *(u32x4*)((bf16_t*)(wsb + WS_KG) + (size_t)row * GKW + (col - 4608)) = pack8(v);
        } else if (col < 6144) {
            *(u32x4*)((bf16_t*)(wsb + WS_VG) + (size_t)row * GVW + (col - 5120)) = pack8(v);
        } else if (col < 7168) {
#pragma unroll
            for (int j = 0; j < 8; ++j) v[j] = v[j] * __builtin_amdgcn_rcpf(1.f + __builtin_amdgcn_exp2f(a[j] * rsn));
            *(u32x4*)((bf16_t*)(wsb + WS_RG) + (size_t)row * GVW + (col - 6144)) = pack8(v);
        } else if (col < 7680) {
            const int c = col - 7168; float lg[8];
            const f32x4 b0 = *(const f32x4*)(bgg + c), b1 = *(const f32x4*)(bgg + c + 4);
#pragma unroll
            for (int j = 0; j < 8; ++j) { const float x = v[j] + (j < 4 ? b0[j] : b1[j - 4]); lg[j] = (fminf(x, 0.f) - __builtin_amdgcn_logf(1.f + __expf(-fabsf(x))) * 0.6931471805599453f) * (1.f / 16.f); }
            *(f32x4*)((float*)(wsb + WS_LOGA) + (size_t)row * GKW + c) = (f32x4){lg[0], lg[1], lg[2], lg[3]}; *(f32x4*)((float*)(wsb + WS_LOGA) + (size_t)row * GKW + c + 4) = (f32x4){lg[4], lg[5], lg[6], lg[7]};
        } else if (col < 9728) {
#pragma unroll
            for (int j = 0; j < 8; ++j) v[j] = __builtin_amdgcn_rcpf(1.f + __builtin_amdgcn_exp2f(a[j] * rsn));
            *(u32x4*)((bf16_t*)(wsb + WS_MH) + (size_t)row * D + (col - 7680)) = pack8(v);
        } else {
#pragma unroll
            for (int j = 0; j < 8; ++j) v[j] = __builtin_amdgcn_rcpf(1.f + __builtin_amdgcn_exp2f(a[j] * rsn));
            *(u32x4*)((bf16_t*)(wsb + WS_MG) + (size_t)row * D + (col - 9728)) = pack8(v);
        }
    }
};
#ifndef PD1
#define PD1 8
#endif
#ifndef PD2
#define PD2 4
#endif
#ifndef PD3
#define PD3 4
#endif
#ifndef PD6
#define PD6 4
#endif
struct FUp1 {
    const bf16_t* mh; bf16_t* T;
    __device__ __forceinline__ float rowctx(int) const { return 0.f; }
    __device__ __forceinline__ void apply8(int row, int col, const float (&a)[8], float) const {
        float g[8], v[8]; unpack8(*(const u32x4*)(mh + (size_t)row * D + col), g);
#pragma unroll
        for (int j = 0; j < 8; ++j) v[j] = a[j] * g[j];
        *(u32x4*)(T + (size_t)row * D + col) = pack8(v);
    }
    struct Pre { u32x4 g; }; static constexpr int PDIST = PD1;
    __device__ __forceinline__ Pre preload(int row, int col) const { return Pre{*(const u32x4*)(mh + (size_t)row * D + col)}; }
    __device__ __forceinline__ void apply8p(int row, int col, const float (&a)[8], const Pre& p) const {
        float g[8], v[8]; unpack8(p.g, g);
#pragma unroll
        for (int j = 0; j < 8; ++j) v[j] = a[j] * g[j];
        *(u32x4*)(T + (size_t)row * D + col) = pack8(v);
    }
};
struct FUp2 {
    const bf16_t* mg; const bf16_t* T; bf16_t* out;
    __device__ __forceinline__ float rowctx(int) const { return 0.f; }
    __device__ __forceinline__ void apply8(int row, int col, const float (&a)[8], float) const {
        float g[8], v[8]; unpack8(*(const u32x4*)(mg + (size_t)row * D + col), g);
        float t[8]; unpack8(*(const u32x4*)(T + (size_t)row * D + col), t);
#pragma unroll
        for (int j = 0; j < 8; ++j) v[j] = t[j] + a[j] * g[j];
        *(u32x4*)(out + (size_t)row * D + col) = pack8(v);
    }
    struct Pre { u32x4 g, t; }; static constexpr int PDIST = PD2;
    __device__ __forceinline__ Pre preload(int row, int col) const { return Pre{*(const u32x4*)(mg + (size_t)row * D + col), *(const u32x4*)(T + (size_t)row * D + col)}; }
    __device__ __forceinline__ void apply8p(int row, int col, const float (&a)[8], const Pre& p) const {
        float g[8], t[8], v[8]; unpack8(p.g, g); unpack8(p.t, t);
#pragma unroll
        for (int j = 0; j < 8; ++j) v[j] = t[j] + a[j] * g[j];
        *(u32x4*)(out + (size_t)row * D + col) = pack8(v);
    }
};
struct FPartS {
    float* dst;
    __device__ __forceinline__ float rowctx(int) const { return 0.f; }
    __device__ __forceinline__ void apply8(int row, int col, const float (&a)[8], float) const {
        float* q = dst + (size_t)(row - MP) * D + col; *(f32x4*)q = (f32x4){a[0], a[1], a[2], a[3]}; *(f32x4*)(q + 4) = (f32x4){a[4], a[5], a[6], a[7]}; }
};
struct FStoreBf {
    bf16_t* T;
    __device__ __forceinline__ float rowctx(int) const { return 0.f; }
    __device__ __forceinline__ void apply8(int row, int col, const float (&a)[8], float) const { float v[8];
#pragma unroll
        for (int j = 0; j < 8; ++j) v[j] = a[j];
        *(u32x4*)(T + (size_t)row * D + col) = pack8(v); }
};
struct FStore32 {
    float* T; int ld;
    __device__ __forceinline__ float rowctx(int) const { return 0.f; }
    __device__ __forceinline__ void apply8(int row, int col, const float (&a)[8], float) const {
        *(f32x4*)(T + (size_t)row * ld + col) = (f32x4){a[0], a[1], a[2], a[3]}; *(f32x4*)(T + (size_t)row * ld + col + 4) = (f32x4){a[4], a[5], a[6], a[7]};
    }
};
struct FRelu2 {
    bf16_t* U; const float* ssq2; const LAS float* rst; int pm0, pm1, pm2, pm3;
    __device__ __forceinline__ float rowctx_g(int row) const {
        const f32x4* p = (const f32x4*)(ssq2 + (size_t)row * 8); const f32x4 x = p[0], y = p[1];
        return rsqrtf((((x[0] + x[1]) + (x[2] + x[3])) + ((y[0] + y[1]) + (y[2] + y[3]))) * (1.f / D) + EPS); }
    __device__ __forceinline__ float rowctx(int row) const {
        const int pm = row >> 8, rl = row & 255;
        if (pm == pm0) return rst[rl];
        if (pm == pm1) return rst[256 + rl];
        if (pm == pm2) return rst[512 + rl];
        if (pm == pm3) return rst[768 + rl];
        return rowctx_g(row); }
    __device__ __forceinline__ void apply8(int row, int col, const float (&a)[8], float rs) const {
        float v[8];
#pragma unroll
        for (int j = 0; j < 8; ++j) { const float r = fmaxf(a[j], 0.f) * rs; v[j] = r * r; }
        *(u32x4*)(U + (size_t)row * DFF + col) = pack8(v);
    }
};
struct FPe {
    bf16_t* O;
    __device__ __forceinline__ float rowctx(int) const { return 0.f; }
    __device__ __forceinline__ void apply8(int row, int col, const float (&a)[8], float) const { float v[8];
#pragma unroll
        for (int j = 0; j < 8; ++j) v[j] = a[j];
        *(u32x4*)(O + (size_t)row * D + col) = pack8(v); }
};
struct FPeD {
    bf16_t* pe;
    __device__ __forceinline__ float rowctx(int) const { return 0.f; }
    __device__ __forceinline__ void apply8(int row, int col, const float (&a)[8], float) const { float v[8]; const int ll = col >> 11;
#pragma unroll
        for (int j = 0; j < 8; ++j) v[j] = a[j];
        *(u32x4*)(pe + ((size_t)ll * MR + (row - ll * MP)) * D + (col & (D - 1))) = pack8(v); }
};
struct DiagOrder {
    int G, c;
    __device__ __forceinline__ bool next(int i, pg8::Unit& u) const { const int L = i * G + c; if (L >= DEPTH * 256) return false; const int ll = L >> 8, r = L & 255; u.pm = ll * 32 + (r >> 3); u.pn = ll * 8 + (r & 7); return true; }
    __device__ __forceinline__ void a_ready(const pg8::Unit&) const {}
    __device__ __forceinline__ void done(const pg8::Unit&) const {}
};
struct FPle {
    const bf16_t* h2; float* out32; bf16_t* hbf; const bf16_t* pe;
    __device__ __forceinline__ float apply8s(int row, int col, const float (&a)[8]) const {
        float e[8], v[8]; unpack8(*(const u32x4*)(pe + (size_t)row * D + col), e);
        float hh[8]; unpack8(*(const u32x4*)(h2 + (size_t)row * D + col), hh); float s = 0.f;
#pragma unroll
        for (int j = 0; j < 8; ++j) { v[j] = hh[j] + sigm(a[j]) * e[j]; s += v[j] * v[j]; }
        if (out32) { *(f32x4*)(out32 + (size_t)row * D + col) = (f32x4){v[0], v[1], v[2], v[3]}; *(f32x4*)(out32 + (size_t)row * D + col + 4) = (f32x4){v[4], v[5], v[6], v[7]}; }
        *(u32x4*)(hbf + (size_t)row * D + col) = pack8(v);
        return s;
    }
    struct Pre { u32x4 e, hh; }; static constexpr int PDIST = PD3;
    __device__ __forceinline__ Pre preload(int row, int col) const { return Pre{*(const u32x4*)(pe + (size_t)row * D + col), *(const u32x4*)(h2 + (size_t)row * D + col)}; }
    __device__ __forceinline__ float apply8sp(int row, int col, const float (&a)[8], const Pre& p) const {
        float e[8], hh[8], v[8]; unpack8(p.e, e); unpack8(p.hh, hh); float s = 0.f;
#pragma unroll
        for (int j = 0; j < 8; ++j) { v[j] = hh[j] + sigm(a[j]) * e[j]; s += v[j] * v[j]; }
        if (out32) { *(f32x4*)(out32 + (size_t)row * D + col) = (f32x4){v[0], v[1], v[2], v[3]}; *(f32x4*)(out32 + (size_t)row * D + col + 4) = (f32x4){v[4], v[5], v[6], v[7]}; }
        *(u32x4*)(hbf + (size_t)row * D + col) = pack8(v);
        return s;
    }
};

template <class F> struct EpiA {
    static constexpr bool PERM = true, AFTER_DRAIN = false; F f;
    __device__ __forceinline__ void operator()(const f32x4 (&acc)[2][2][4][2], const pg8::Unit& u, int wr, int wc, int fr, int fq) const {
#pragma unroll
        for (int ai = 0; ai < 2; ++ai)
#pragma unroll
            for (int m = 0; m < 4; ++m) { const int row = u.pm * 256 + ai * 128 + wr * 64 + m * 16 + fr; const float ctx = f.rowctx(row);
#pragma unroll
                for (int bj = 0; bj < 2; ++bj) { const int col = u.pn * 256 + bj * 128 + wc * 32 + 8 * fq;
                    const float v[8] = {acc[ai][bj][m][0][0], acc[ai][bj][m][0][1], acc[ai][bj][m][0][2], acc[ai][bj][m][0][3], acc[ai][bj][m][1][0], acc[ai][bj][m][1][1], acc[ai][bj][m][1][2], acc[ai][bj][m][1][3]};
                    f.apply8(row, col, v, ctx); } }
    }
};
template <class F> struct EpiAP {
    static constexpr bool PERM = true, AFTER_DRAIN = false; F f;
    __device__ __forceinline__ void operator()(const f32x4 (&acc)[2][2][4][2], const pg8::Unit& u, int wr, int wc, int fr, int fq) const {
        typename F::Pre pre[16];
        const int row0 = u.pm * 256 + wr * 64 + fr, col0 = u.pn * 256 + wc * 32 + 8 * fq;
#define EPG_ROW(g) (row0 + ((g) >> 3) * 128 + (((g) >> 1) & 3) * 16)
#define EPG_COL(g) (col0 + ((g) & 1) * 128)
#pragma unroll
        for (int g = 0; g < F::PDIST; ++g) pre[g] = f.preload(EPG_ROW(g), EPG_COL(g));
        __builtin_amdgcn_sched_barrier(0);
#pragma unroll
        for (int g = 0; g < 16; ++g) { const int ai = g >> 3, m = (g >> 1) & 3, bj = g & 1;
            if (g + F::PDIST < 16) { pre[(g + F::PDIST) & 15] = f.preload(EPG_ROW(g + F::PDIST), EPG_COL(g + F::PDIST)); __builtin_amdgcn_sched_barrier(0); }
            const float v[8] = {acc[ai][bj][m][0][0], acc[ai][bj][m][0][1], acc[ai][bj][m][0][2], acc[ai][bj][m][0][3], acc[ai][bj][m][1][0], acc[ai][bj][m][1][1], acc[ai][bj][m][1][2], acc[ai][bj][m][1][3]};
            f.apply8p(EPG_ROW(g), EPG_COL(g), v, pre[g]);
            __builtin_amdgcn_sched_barrier(0); }
    }
};
struct EpiPle {
    static constexpr bool PERM = true, AFTER_DRAIN = true; FPle f; float* ssq;
    __device__ __forceinline__ void operator()(const f32x4 (&)[2][2][4][2], const pg8::Unit&, int, int, int, int) const {}
    __device__ __forceinline__ void fused(f32x4 (&acc)[2][2][4][2], const pg8::Unit& u, int wr, int wc, int fr, int fq, LAS unsigned char* lds, int wid, int lane) const {
        LAS float* Pq = (LAS float*)lds;
        FPle::Pre pre[16];
        const int row0 = u.pm * 256 + wr * 64 + fr, col0 = u.pn * 256 + wc * 32 + 8 * fq;
#pragma unroll
        for (int g = 0; g < FPle::PDIST; ++g) pre[g] = f.preload(EPG_ROW(g), EPG_COL(g));
        __builtin_amdgcn_sched_barrier(0);
        float s = 0.f;
#pragma unroll
        for (int g = 0; g < 16; ++g) { const int ai = g >> 3, m = (g >> 1) & 3, bj = g & 1;
            if (g + FPle::PDIST < 16) { pre[(g + FPle::PDIST) & 15] = f.preload(EPG_ROW(g + FPle::PDIST), EPG_COL(g + FPle::PDIST)); __builtin_amdgcn_sched_barrier(0); }
            const float v[8] = {acc[ai][bj][m][0][0], acc[ai][bj][m][0][1], acc[ai][bj][m][0][2], acc[ai][bj][m][0][3], acc[ai][bj][m][1][0], acc[ai][bj][m][1][1], acc[ai][bj][m][1][2], acc[ai][bj][m][1][3]};
            s += f.apply8sp(EPG_ROW(g), EPG_COL(g), v, pre[g]);
            if (bj == 1) { s += __shfl_xor(s, 16); s += __shfl_xor(s, 32);
                if (fq == 0) Pq[(ai * 128 + wr * 64 + m * 16 + fr) * 4 + wc] = s;
                s = 0.f; }
            __builtin_amdgcn_sched_barrier(0); }
        asm volatile("s_waitcnt lgkmcnt(0)" ::: "memory"); __builtin_amdgcn_s_barrier(); asm volatile("" ::: "memory");
        const int t = wid * 64 + lane;
        if (t < 256) { const f32x4 q = *(const LAS f32x4*)(Pq + t * 4); ssq[(size_t)(u.pm * 256 + t) * SSQW + u.pn] = (q[0] + q[1]) + (q[2] + q[3]); }
        asm volatile("s_waitcnt lgkmcnt(0)" ::: "memory"); __builtin_amdgcn_s_barrier(); asm volatile("" ::: "memory");
    }
};

__device__ __forceinline__ void ld_sc1_2x4(const float* p, f32x4& a, f32x4& b) {
    asm volatile("global_load_dwordx4 %0, %2, off sc1\n\tglobal_load_dwordx4 %1, %2, off offset:16 sc1\n\ts_waitcnt vmcnt(0)" : "=&v"(a), "=&v"(b) : "v"(p) : "memory"); }
__device__ __forceinline__ void ld_sc1_4x4(const float* p0, const float* p1, const float* p2, const float* p3, f32x4& a, f32x4& b, f32x4& c, f32x4& d) {
    asm volatile("global_load_dwordx4 %0, %4, off sc1\n\tglobal_load_dwordx4 %1, %5, off sc1\n\tglobal_load_dwordx4 %2, %6, off sc1\n\tglobal_load_dwordx4 %3, %7, off sc1\n\ts_waitcnt vmcnt(0)"
                 : "=&v"(a), "=&v"(b), "=&v"(c), "=&v"(d) : "v"(p0), "v"(p1), "v"(p2), "v"(p3) : "memory"); }
__device__ __forceinline__ void panel_rstd(const f32x4 (&acc)[2][2][4][2], const pg8::Unit& u, int wr, int wc, int fr, int fq, LAS float* Pq, LAS float* S, float* xbuf, unsigned* cnt, unsigned* tmo, int wid, int lane) {
#pragma unroll
    for (int ai = 0; ai < 2; ++ai)
#pragma unroll
        for (int m = 0; m < 4; ++m) { float s = 0.f;
#pragma unroll
            for (int bj = 0; bj < 2; ++bj)
#pragma unroll
                for (int n = 0; n < 2; ++n) { const f32x4 x = acc[ai][bj][m][n]; s += (x[0] * x[0] + x[1] * x[1]) + (x[2] * x[2] + x[3] * x[3]); }
            s += __shfl_xor(s, 16); s += __shfl_xor(s, 32);
            if (fq == 0) Pq[(ai * 128 + wr * 64 + m * 16 + fr) * 4 + wc] = s; }
    const int t = wid * 64 + lane;
    asm volatile("s_waitcnt lgkmcnt(0)" ::: "memory"); __builtin_amdgcn_s_barrier(); asm volatile("" ::: "memory");
    if (t < 256) { const f32x4 q = *(const LAS f32x4*)(Pq + t * 4);
        __hip_atomic_store(xbuf + (size_t)(u.pm * 256 + t) * 8 + u.pn, (q[0] + q[1]) + (q[2] + q[3]), __ATOMIC_RELAXED, __HIP_MEMORY_SCOPE_AGENT); }
    asm volatile("s_waitcnt vmcnt(0)" ::: "memory");
    if (wid < 4 && lane == 0) __hip_atomic_fetch_add(cnt + 64 * u.pm, 1u, __ATOMIC_RELAXED, __HIP_MEMORY_SCOPE_AGENT);
    if (wid == 0) { unsigned sp = 0u;
        while ((unsigned)__builtin_amdgcn_readfirstlane(__hip_atomic_load(cnt + 64 * u.pm, __ATOMIC_RELAXED, __HIP_MEMORY_SCOPE_AGENT)) < 32u) {
            __builtin_amdgcn_s_sleep(1);
            if ((++sp & 255u) == 0u) { if (__hip_atomic_load(tmo, __ATOMIC_RELAXED, __HIP_MEMORY_SCOPE_AGENT)) break; if (sp > (1u << 18)) { if (lane == 0) atomicAdd(tmo, 1u); break; } } }
        __builtin_amdgcn_fence(__ATOMIC_ACQUIRE, "agent"); }
    asm volatile("s_waitcnt vmcnt(0) lgkmcnt(0)" ::: "memory"); __builtin_amdgcn_s_barrier(); asm volatile("" ::: "memory");
    if (t < 256) { const float* slot = xbuf + (size_t)(u.pm * 256 + t) * 8; f32x4 a, b; ld_sc1_2x4(slot, a, b);
        const float s = ((a[0] + a[1]) + (a[2] + a[3])) + ((b[0] + b[1]) + (b[2] + b[3]));
        S[t] = rsqrtf(s * (1.f / D) + EPS); }
    asm volatile("s_waitcnt vmcnt(0) lgkmcnt(0)" ::: "memory"); __builtin_amdgcn_s_barrier(); asm volatile("" ::: "memory");
}
struct EpiPost6 {
    static constexpr bool PERM = true, AFTER_DRAIN = true;
    const bf16_t* h1; const float* g3; bf16_t* hdst; float* xbuf; unsigned* cnt; unsigned* tmo;
    struct Pre { u32x4 hh; };
    __device__ __forceinline__ Pre preload(int row, int col) const { return Pre{*(const u32x4*)(h1 + (size_t)row * D + col)}; }
    __device__ __forceinline__ void operator()(const f32x4 (&)[2][2][4][2], const pg8::Unit&, int, int, int, int) const {}
    __device__ __forceinline__ void fused(f32x4 (&acc)[2][2][4][2], const pg8::Unit& u, int wr, int wc, int fr, int fq, LAS unsigned char* lds, int wid, int lane) const {
        LAS float* Pq = (LAS float*)lds;
        LAS float* S3 = (LAS float*)(lds + 4096);
        LAS float* G3 = (LAS float*)(lds + 7168);
        const int row0 = u.pm * 256 + wr * 64 + fr, col0 = u.pn * 256 + wc * 32 + 8 * fq;
        Pre pre[16];
#pragma unroll
        for (int g = 0; g < PD6; ++g) pre[g] = preload(EPG_ROW(g), EPG_COL(g));
        const int t = wid * 64 + lane;
        if (t >= 256) G3[t - 256] = g3[u.pn * 256 + t - 256];
        panel_rstd(acc, u, wr, wc, fr, fq, Pq, S3, xbuf, cnt, tmo, wid, lane);
        __builtin_amdgcn_sched_barrier(0);
#pragma unroll
        for (int g = 0; g < 16; ++g) { const int ai = g >> 3, m = (g >> 1) & 3, bj = g & 1;
            if (g + PD6 < 16) { pre[(g + PD6) & 15] = preload(EPG_ROW(g + PD6), EPG_COL(g + PD6)); __builtin_amdgcn_sched_barrier(0); }
            const int rl = ai * 128 + wr * 64 + m * 16 + fr, cl = bj * 128 + wc * 32 + 8 * fq;
            const float r3 = S3[rl];
            const f32x4 fa = *(const LAS f32x4*)(G3 + cl) * r3, fb = *(const LAS f32x4*)(G3 + cl + 4) * r3;
            float hh[8], v[8]; unpack8(pre[g].hh, hh);
#pragma unroll
            for (int j = 0; j < 4; ++j) { v[j] = hh[j] + acc[ai][bj][m][0][j] * fa[j]; v[4 + j] = hh[4 + j] + acc[ai][bj][m][1][j] * fb[j]; }
            *(u32x4*)(hdst + (size_t)EPG_ROW(g) * D + EPG_COL(g)) = pack8(v);
            __builtin_amdgcn_sched_barrier(0); }
    }
};
struct EpiPost4 {
    static constexpr bool PERM = true, AFTER_DRAIN = true;
    const bf16_t* h; const float* g1; bf16_t* h1dst; float* ssq2; float* xbuf; unsigned* cnt; unsigned* tmo;
    struct Pre { u32x4 hh; };
    __device__ __forceinline__ Pre preload(int row, int col) const { return Pre{*(const u32x4*)(h + (size_t)row * D + col)}; }
    __device__ __forceinline__ void operator()(const f32x4 (&)[2][2][4][2], const pg8::Unit&, int, int, int, int) const {}
    __device__ __forceinline__ void fused(f32x4 (&acc)[2][2][4][2], const pg8::Unit& u, int wr, int wc, int fr, int fq, LAS unsigned char* lds, int wid, int lane) const {
        LAS float* Pq = (LAS float*)lds;
        LAS float* S1 = (LAS float*)(lds + 4096);
        LAS float* G1 = (LAS float*)(lds + 7168);
        const int row0 = u.pm * 256 + wr * 64 + fr, col0 = u.pn * 256 + wc * 32 + 8 * fq;
        Pre pre[16];
#pragma unroll
        for (int g = 0; g < PD6; ++g) pre[g] = preload(EPG_ROW(g), EPG_COL(g));
        const int t = wid * 64 + lane;
        if (t >= 256) G1[t - 256] = g1[u.pn * 256 + t - 256];
        panel_rstd(acc, u, wr, wc, fr, fq, Pq, S1, xbuf, cnt, tmo, wid, lane);
        __builtin_amdgcn_sched_barrier(0);
        float s2 = 0.f;
#pragma unroll
        for (int g = 0; g < 16; ++g) { const int ai = g >> 3, m = (g >> 1) & 3, bj = g & 1;
            if (g + PD6 < 16) { pre[(g + PD6) & 15] = preload(EPG_ROW(g + PD6), EPG_COL(g + PD6)); __builtin_amdgcn_sched_barrier(0); }
            const int rl = ai * 128 + wr * 64 + m * 16 + fr, cl = bj * 128 + wc * 32 + 8 * fq;
            const float r1 = S1[rl];
            const f32x4 ga = *(const LAS f32x4*)(G1 + cl) * r1, gb = *(const LAS f32x4*)(G1 + cl + 4) * r1;
            float hh[8], v[8]; unpack8(pre[g].hh, hh);
#pragma unroll
            for (int j = 0; j < 4; ++j) { v[j] = hh[j] + acc[ai][bj][m][0][j] * ga[j]; v[4 + j] = hh[4 + j] + acc[ai][bj][m][1][j] * gb[j]; }
#pragma unroll
            for (int j = 0; j < 8; ++j) s2 += v[j] * v[j];
            *(u32x4*)(h1dst + (size_t)EPG_ROW(g) * D + EPG_COL(g)) = pack8(v);
            if (bj == 1) { s2 += __shfl_xor(s2, 16); s2 += __shfl_xor(s2, 32);
                if (fq == 0) Pq[rl * 4 + wc] = s2;
                s2 = 0.f; }
            __builtin_amdgcn_sched_barrier(0); }
        asm volatile("s_waitcnt lgkmcnt(0)" ::: "memory"); __builtin_amdgcn_s_barrier(); asm volatile("" ::: "memory");
        if (t < 256) { const f32x4 q = *(const LAS f32x4*)(Pq + t * 4); ssq2[(size_t)(u.pm * 256 + t) * 8 + u.pn] = (q[0] + q[1]) + (q[2] + q[3]); }
        asm volatile("s_waitcnt lgkmcnt(0)" ::: "memory"); __builtin_amdgcn_s_barrier(); asm volatile("" ::: "memory");
    }
};

__device__ __forceinline__ void transpose_item(const float* W, int ldw, const float* kgain, float scale, bf16_t* WT, int ldt, int k0, int n_src0, int n_dst0, LAS float* scr, int lane) {
    float wv[32];
#pragma unroll
    for (int i = 0; i < 32; ++i) wv[i] = W[(size_t)(k0 + 2 * i + (lane >> 5)) * ldw + n_src0 + (lane & 31)];
    if (kgain) {
#pragma unroll
        for (int i = 0; i < 32; ++i) wv[i] *= kgain[k0 + 2 * i + (lane >> 5)] * scale; }
#pragma unroll
    for (int i = 0; i < 32; ++i) scr[(2 * i + (lane >> 5)) * 33 + (lane & 31)] = wv[i];
    asm volatile("s_waitcnt lgkmcnt(0)" ::: "memory");
    const int c = lane & 7;
#pragma unroll
    for (int j = 0; j < 4; ++j) { const int n = (lane >> 3) + 8 * j; const LAS float* s = scr + (8 * c) * 33 + n;
        u32x4 o; o.x = pk2(s[0 * 33], s[1 * 33]); o.y = pk2(s[2 * 33], s[3 * 33]); o.z = pk2(s[4 * 33], s[5 * 33]); o.w = pk2(s[6 * 33], s[7 * 33]);
        *(u32x4*)(WT + (size_t)(n_dst0 + n) * ldt + k0 + 8 * c) = o; }
    asm volatile("s_waitcnt lgkmcnt(0)" ::: "memory");
}
__device__ __forceinline__ void fold_item(const float* Win, const float* wgg, const float* kgain, bf16_t* WT, int k0, int j0, int n_dst0, LAS float* scr, int lane) {
    float wg[GR];
#pragma unroll
    for (int r = 0; r < GR; ++r) wg[r] = wgg[r * GKW + j0 + (lane & 31)];
#pragma unroll 8
    for (int i = 0; i < 32; ++i) { const int kk = 2 * i + (lane >> 5); const f32x4* wr = (const f32x4*)(Win + (size_t)(k0 + kk) * NIN + C_GLR); float s = 0.f;
#pragma unroll
        for (int r4 = 0; r4 < GR / 4; ++r4) { const f32x4 x = wr[r4]; s += (x[0] * wg[4 * r4] + x[1] * wg[4 * r4 + 1]) + (x[2] * wg[4 * r4 + 2] + x[3] * wg[4 * r4 + 3]); }
        scr[kk * 33 + (lane & 31)] = s * kgain[k0 + kk]; }
    asm volatile("s_waitcnt lgkmcnt(0)" ::: "memory");
    const int c = lane & 7;
#pragma unroll
    for (int j = 0; j < 4; ++j) { const int n = (lane >> 3) + 8 * j; const LAS float* s = scr + (8 * c) * 33 + n;
        u32x4 o; o.x = pk2(s[0 * 33], s[1 * 33]); o.y = pk2(s[2 * 33], s[3 * 33]); o.z = pk2(s[4 * 33], s[5 * 33]); o.w = pk2(s[6 * 33], s[7 * 33]);
        *(u32x4*)(WT + (size_t)(n_dst0 + n) * D + k0 + 8 * c) = o; }
    asm volatile("s_waitcnt lgkmcnt(0)" ::: "memory");
}

__device__ __forceinline__ void phase_prologue(const P& p, unsigned char* ws, LAS unsigned char* lds, int wg, int nwg) {
    const int tid = tidx(), lane = tid & 63, wave = tid >> 6;
    LAS float* scr = (LAS float*)(lds + wave * 16384);
    const int gw = wg * NWAVES + wave, NGW = nwg * NWAVES;
    constexpr int I_IN = (D / 64) * (NZ / 32), I_UH = (HW / 64) * (D / 32), I_UG = I_UH, I_OUT = (D / 64) * (D / 32), I_F1 = (D / 64) * (DFF / 32), I_F2 = (DFF / 64) * (D / 32), I_PL = (PLE / 64) * (D / 32), I_PG = I_OUT;
    constexpr int I_LAYER = I_IN + I_UH + I_UG + I_OUT + I_F1 + I_F2 + I_PL + I_PG;
    for (int it = gw; it < DEPTH * I_LAYER; it += NGW) {
        const int l = it / I_LAYER; int r = it % I_LAYER;
        if (r < I_IN) { const int nb = r % (NZ / 32), kb = r / (NZ / 32), n0 = nb * 32; bf16_t* WT = (bf16_t*)(ws + WS_WIN) + (size_t)l * NZ * D; const float* Win = p.w_in + (size_t)l * D * NIN; const float* kg = p.n_pre_mix + l * D;
            if (n0 >= 7168 && n0 < 7680) fold_item(Win, p.wgg + (size_t)l * GR * GKW, kg, WT, kb * 64, n0 - 7168, n0, scr, lane);
            else { const int ns = n0 < 7168 ? n0 : n0 - 496; const float sc = (n0 >= 4096 && n0 < 4608) ? 0.08838834764831845f : 1.f; transpose_item(Win, NIN, kg, sc, WT, D, kb * 64, ns, n0, scr, lane); }
            continue; } r -= I_IN;
        if (r < I_UH) { transpose_item(p.w_hup + (size_t)l * HW * D, D, nullptr, 1.f, (bf16_t*)(ws + WS_WUH) + (size_t)l * D * HW, HW, (r / (D / 32)) * 64, (r % (D / 32)) * 32, (r % (D / 32)) * 32, scr, lane); continue; } r -= I_UH;
        if (r < I_UG) { transpose_item(p.w_gup + (size_t)l * GVW * D, D, nullptr, 1.f, (bf16_t*)(ws + WS_WUG) + (size_t)l * D * GVW, GVW, (r / (D / 32)) * 64, (r % (D / 32)) * 32, (r % (D / 32)) * 32, scr, lane); continue; } r -= I_UG;
        if (r < I_OUT) { transpose_item(p.w_out + (size_t)l * D * D, D, nullptr, 1.f, (bf16_t*)(ws + WS_WOUT) + (size_t)l * D * D, D, (r / (D / 32)) * 64, (r % (D / 32)) * 32, (r % (D / 32)) * 32, scr, lane); continue; } r -= I_OUT;
        if (r < I_F1) { transpose_item(p.w_ff1 + (size_t)l * D * DFF, DFF, p.n_pre_ffn + l * D, 1.f, (bf16_t*)(ws + WS_WFF1) + (size_t)l * DFF * D, D, (r / (DFF / 32)) * 64, (r % (DFF / 32)) * 32, (r % (DFF / 32)) * 32, scr, lane); continue; } r -= I_F1;
        if (r < I_F2) { transpose_item(p.w_ff2 + (size_t)l * DFF * D, D, nullptr, 1.f, (bf16_t*)(ws + WS_WFF2) + (size_t)l * D * DFF, DFF, (r / (D / 32)) * 64, (r % (D / 32)) * 32, (r % (D / 32)) * 32, scr, lane); continue; } r -= I_F2;
        if (r < I_PL) { transpose_item(p.w_ple + (size_t)l * PLE * D, D, nullptr, 1.f, (bf16_t*)(ws + WS_WPLE) + (size_t)l * D * PLE, PLE, (r / (D / 32)) * 64, (r % (D / 32)) * 32, (r % (D / 32)) * 32, scr, lane); continue; } r -= I_PL;
        transpose_item(p.w_plg + (size_t)l * D * D, D, nullptr, 1.f, (bf16_t*)(ws + WS_WPLG) + (size_t)l * D * D, D, (r / (D / 32)) * 64, (r % (D / 32)) * 32, (r % (D / 32)) * 32, scr, lane);
    }
    float* lbs = (float*)(ws + WS_LBS);
    for (int c = wg * NTHR + tid; c < HW; c += nwg * NTHR) {
        float e[DEPTH], mx = -1e30f, sum = 0.f;
#pragma unroll
        for (int i = 0; i < DEPTH; ++i) { e[i] = p.lbp[i * HW + c]; mx = fmaxf(mx, e[i]); }
#pragma unroll
        for (int i = 0; i < DEPTH; ++i) { e[i] = __expf(e[i] - mx); sum += e[i]; }
        float acc = 0.f; lbs[c] = 0.f;
#pragma unroll
        for (int i = 1; i < DEPTH; ++i) { acc += e[i]; lbs[i * HW + c] = acc / sum; }
    }
    { bf16_t* pbf = (bf16_t*)(ws + WS_PBF);
      constexpr size_t NPP = (size_t)DEPTH * MP * PLE, NPS = (size_t)DEPTH * DECB * PLE;
      for (size_t i = ((size_t)wg * NTHR + tid) * 4; i < NPP + NPS; i += (size_t)nwg * NTHR * 4) {
          const float* src = i < NPP ? p.pp + i : p.ps + (i - NPP);
          const f32x4 v = *(const f32x4*)src; u32x2 w; w.x = pk2(v[0], v[1]); w.y = pk2(v[2], v[3]); *(u32x2*)(pbf + i) = w; } }
    bf16_t* hbf = (bf16_t*)(ws + WS_HBF); float* ssq = (float*)(ws + WS_SSQ);
    for (int row = gw; row < MT; row += NGW) {
        const float* src = row < MP ? p.xp + (size_t)row * D : p.xs + (size_t)(row - MP) * D; float s = 0.f;
#pragma unroll
        for (int j = 0; j < 8; ++j) { const f32x4 v = *(const f32x4*)(src + j * 256 + lane * 4); s += (v[0] * v[0] + v[1] * v[1]) + (v[2] * v[2] + v[3] * v[3]);
            u32x2 w; w.x = pk2(v[0], v[1]); w.y = pk2(v[2], v[3]); *(u32x2*)(hbf + (size_t)row * D + j * 256 + lane * 4) = w; }
        s = wave_sum(s);
        if (lane < SSQW) ssq[(size_t)row * SSQW + lane] = lane == 0 ? s : 0.f;
    }
}

constexpr size_t WS_T4 = WS_T32, WS_T6 = WS_T32 + (size_t)MR * D * 2;
constexpr size_t WS_PART4 = WS_PART, WS_PART6 = WS_PART + (size_t)4 * DECB * D * 4;
__device__ __forceinline__ float ssq4(const f32x4 x) { return (x[0] * x[0] + x[1] * x[1]) + (x[2] * x[2] + x[3] * x[3]); }
__device__ __forceinline__ f32x4 unpk4(const u32x2 w) { return (f32x4){__uint_as_float(w.x << 16), __uint_as_float(w.x & 0xffff0000u), __uint_as_float(w.y << 16), __uint_as_float(w.y & 0xffff0000u)}; }
template <int MODE> __device__ __forceinline__ void thin_post(unsigned char* ws, LAS unsigned char* lds, const bf16_t* hcur, const float* g1, const float* g2, const float* g3, bf16_t* hbf_dst, int wg, int nwg) {
    const int lane = tidx() & 63, wave = tidx() >> 6;
    LAS float* red = (LAS float*)lds;
    for (int r = wg; r < DECB; r += nwg) {
        const int row = MP + r, col = wave * 256 + lane * 4;
        const float* p4 = (const float*)(ws + WS_PART4) + (size_t)r * D + col; f32x4 t = *(const f32x4*)p4;
        f32x4 u = (f32x4){0.f, 0.f, 0.f, 0.f};
        if constexpr (MODE == 1) { const float* p6 = (const float*)(ws + WS_PART6) + (size_t)r * D + col; u = *(const f32x4*)p6;
#pragma unroll
            for (int ks = 1; ks < 4; ++ks) u += *(const f32x4*)(p6 + (size_t)ks * DECB * D); }
        const f32x4 h = unpk4(*(const u32x2*)(hcur + (size_t)row * D + col));
        const float s1 = wave_sum(ssq4(t)), s3 = wave_sum(ssq4(u));
        __syncthreads();
        if (lane == 0) { red[wave] = s1; red[8 + wave] = s3; }
        __syncthreads();
        float S1 = 0.f, S3 = 0.f;
#pragma unroll
        for (int k = 0; k < 8; ++k) { S1 += red[k]; S3 += red[8 + k]; }
        const float rs1 = rsqrtf(S1 * (1.f / D) + EPS);
        const f32x4 h1 = h + t * rs1 * *(const f32x4*)(g1 + col);
        if constexpr (MODE == 0) {
            const float s2 = wave_sum(ssq4(h1));
            if (lane == 0) red[16 + wave] = s2;
            __syncthreads();
            float S2 = 0.f;
#pragma unroll
            for (int k = 0; k < 8; ++k) S2 += red[16 + k];
            u32x2 w; w.x = pk2(h1[0], h1[1]); w.y = pk2(h1[2], h1[3]); *(u32x2*)((bf16_t*)(ws + WS_T4) + (size_t)row * D + col) = w;
            if (tidx() < 8) ((float*)(ws + WS_CTL))[CW_SSQ2 + (size_t)row * 8 + tidx()] = tidx() == 0 ? S2 : 0.f;
        } else {
            const f32x4 h2 = h1 + u * rsqrtf(S3 * (1.f / D) + EPS) * *(const f32x4*)(g3 + col);
            u32x2 w; w.x = pk2(h2[0], h2[1]); w.y = pk2(h2[2], h2[3]); *(u32x2*)(hbf_dst + (size_t)row * D + col) = w;
        }
    }
}

constexpr size_t OUT_HP = (size_t)MT * D;
constexpr size_t OUT_GP = OUT_HP + (size_t)DEPTH * BATCH * HH * HK * HV;
constexpr size_t OUT_HS = OUT_GP + (size_t)DEPTH * BATCH * GH * GK * GV;
constexpr size_t OUT_GS = OUT_HS + (size_t)DEPTH * DECB * HH * HK * HV;
constexpr int SQ = 272, SK = 144;
constexpr int R_QA = 0, R_PP = R_QA + 64 * SQ, R_KBT = R_PP + 64 * SK, R_DEC = R_KBT + 128 * SK, IMG_BYTES = R_DEC + 512;
constexpr int R_VT = IMG_BYTES, R_ST0 = R_VT + 64 * SK, R_ST1 = R_ST0 + 64 * SQ, R_END = R_ST1 + 64 * SQ;
constexpr int R_OSQ = R_END, R_ORS = R_OSQ + SEQ * 2 * 4, R_OEND = R_ORS + SEQ * 4;
static_assert(R_OEND <= 131072, "recurrence LDS map (head-norm tables)");
constexpr int RP_KA = IMG_BYTES, RP_SEG = RP_KA + 64 * SQ;
static_assert(R_END <= 131072 && IMG_BYTES % 256 == 0, "recurrence LDS / image map");
constexpr int NSH = BATCH * HH + BATCH * GH;
constexpr size_t WS_IMG = WS_MRG;
constexpr size_t WS_EMID = WS_IMG + (size_t)NSH * 32 * IMG_BYTES;
constexpr size_t WS_XO = WS_EMID + (size_t)NSH * 32 * 128 * 4;
static_assert(WS_XO + (size_t)NSH * 4 * SEQ * 4 <= WS_MRG + (size_t)MR * D * 2 + (size_t)MR * DFF * 2, "chunk images + head-norm exchange fit in MRG | U");
constexpr int CW_TMO = 1024 + 128;
constexpr int CW_OCNT = 231424;
static_assert((size_t)(CW_OCNT + DEPTH * NSH * 64) * 4 <= CTL_BYTES && CW_OCNT >= CW_SSQ2 + MR * 8, "head-norm counters");
typedef short bf16x8_t __attribute__((ext_vector_type(8)));
#define MFMA16(a, b, c) __builtin_amdgcn_mfma_f32_16x16x32_bf16((a), (b), (c), 0, 0, 0)

__device__ __forceinline__ void rec_prep_task(unsigned char* ws, LAS unsigned char* lds, int tkp) {
    const int tid = tidx();
    const int shg = tkp >> 5, ch = tkp & 31; const bool gla = shg >= BATCH * HH; const int sh = gla ? shg - BATCH * HH : shg;
    const int nheads = gla ? GH : HH, b = sh / nheads, head = sh % nheads, ldk = gla ? GKW : HW;
    const size_t row0 = (size_t)(b * SEQ + ch * 64);
    const bf16_t* qp = (const bf16_t*)(ws + (gla ? WS_QG : WS_QH)) + row0 * ldk + head * 128;
    const bf16_t* kp = (const bf16_t*)(ws + (gla ? WS_KG : WS_KH)) + row0 * ldk + head * 128;
    const float* gp = (const float*)(ws + (gla ? WS_LOGA : WS_LOGF)) + row0 * ldk + head * 128;
    unsigned char* img = ws + WS_IMG + (size_t)tkp * IMG_BYTES;
    const int c = tid & 127, tq = tid >> 7;
    float gr[16]; bf16_t qr[16], kr[16];
#pragma unroll
    for (int i = 0; i < 16; ++i) { const size_t t = (size_t)(tq * 16 + i); gr[i] = gp[t * ldk + c]; qr[i] = qp[t * ldk + c]; kr[i] = kp[t * ldk + c]; }
    float pf[16]; float run = 0.f;
#pragma unroll
    for (int i = 0; i < 16; ++i) { run += gr[i]; pf[i] = run; }
    __syncthreads();
    ((LAS float*)(lds + RP_SEG))[tq * 128 + c] = run;
    __syncthreads();
    const float s0 = ((LAS float*)(lds + RP_SEG))[c], s1 = ((LAS float*)(lds + RP_SEG))[128 + c], s2 = ((LAS float*)(lds + RP_SEG))[256 + c], s3 = ((LAS float*)(lds + RP_SEG))[384 + c];
    const float off = tq == 0 ? 0.f : (tq == 1 ? s0 : (tq == 2 ? s0 + s1 : s0 + s1 + s2));
    const float bmid = s0 + s1, blast = (s0 + s1) + (s2 + s3);
    const float Elm = __expf(blast - bmid);
    if (tq == 0) { ((LAS float*)(lds + R_DEC))[c] = __expf(blast); ((float*)(ws + WS_EMID))[(size_t)tkp * 128 + c] = __expf(bmid); }
    float kb[16];
#pragma unroll
    for (int i = 0; i < 16; ++i) {
        const int t = tq * 16 + i;
        const float x = clampf(off + pf[i] - bmid, -60.f, 60.f);
        const float e1 = __expf(x), r1 = __builtin_amdgcn_rcpf(e1);
        const float qa = bf2f(qr[i]) * e1, ka = bf2f(kr[i]) * r1;
        *(LAS bf16_t*)(lds + R_QA + t * SQ + c * 2) = (bf16_t)pk2(qa, 0.f);
        *(LAS bf16_t*)(lds + RP_KA + t * SQ + c * 2) = (bf16_t)pk2(ka, 0.f);
        kb[i] = ka * Elm;
    }
    { u32x4 w0, w1; w0.x = pk2(kb[0], kb[1]); w0.y = pk2(kb[2], kb[3]); w0.z = pk2(kb[4], kb[5]); w0.w = pk2(kb[6], kb[7]);
      w1.x = pk2(kb[8], kb[9]); w1.y = pk2(kb[10], kb[11]); w1.z = pk2(kb[12], kb[13]); w1.w = pk2(kb[14], kb[15]);
      *(LAS u32x4*)(lds + R_KBT + c * SK + tq * 32) = w0; *(LAS u32x4*)(lds + R_KBT + c * SK + tq * 32 + 16) = w1; }
    __syncthreads();
    {
        const int lane = tid & 63, w = tid >> 6, fr = lane & 15, fq = lane >> 4, ti = w >> 1, vi = w & 1;
        bf16x8_t qf[4];
#pragma unroll
        for (int kk = 0; kk < 4; ++kk) qf[kk] = *(const LAS bf16x8_t*)(lds + R_QA + (ti * 16 + fr) * SQ + kk * 64 + fq * 16);
#pragma unroll
        for (int sj = 0; sj < 2; ++sj) { const int si = 2 * vi + sj; f32x4 acc = (f32x4){0.f, 0.f, 0.f, 0.f};
#pragma unroll
            for (int kk = 0; kk < 4; ++kk) { const bf16x8_t a = *(const LAS bf16x8_t*)(lds + RP_KA + (si * 16 + fr) * SQ + kk * 64 + fq * 16); acc = MFMA16(a, qf[kk], acc); }
            const int t = ti * 16 + fr, sb = si * 16 + fq * 4;
            u32x2 wv; wv.x = pk2(sb <= t ? acc[0] : 0.f, sb + 1 <= t ? acc[1] : 0.f); wv.y = pk2(sb + 2 <= t ? acc[2] : 0.f, sb + 3 <= t ? acc[3] : 0.f);
            *(LAS u32x2*)(lds + R_PP + t * SK + sb * 2) = wv; }
    }
    __syncthreads();
    for (int i = tid; i < IMG_BYTES / 16; i += NTHR) *(u32x4*)(img + (size_t)i * 16) = *(const LAS u32x4*)(lds + i * 16);
}

__device__ __forceinline__ void rec_loop_task(const P& p, unsigned char* ws, int l, LAS unsigned char* lds, int tk) {
    const int tid = tidx(), lane = tid & 63, w = __builtin_amdgcn_readfirstlane(tid >> 6), fr = lane & 15, fq = lane >> 4;
    const int xcd = tk & 7, jx = tk >> 3;
    const bool gla = jx >= 8;
    const int sh = gla ? xcd + 8 * ((jx - 8) >> 2) : xcd + 8 * (jx >> 1), vs = gla ? ((jx - 8) & 3) : (jx & 1), V = gla ? GV : HV, nheads = gla ? GH : HH, b = sh / nheads, head = sh % nheads;
    const int shg = gla ? sh + BATCH * HH : sh;
    const unsigned char* img0 = ws + WS_IMG + (size_t)shg * 32 * IMG_BYTES;
    const float* em0 = (const float*)(ws + WS_EMID) + (size_t)shg * 32 * 128 + (w >> 1) * 32 + fq * 4;
    const bf16_t* vp = (const bf16_t*)(ws + (gla ? WS_VG : WS_VH)) + (size_t)(b * SEQ) * 1024 + head * V + vs * 64;
    float* op = (float*)(ws + WS_T32) + (size_t)(b * SEQ) * D + (gla ? 1024 : 0) + head * V + vs * 64;
    float* sp = p.out + (gla ? OUT_GP : OUT_HP) + (size_t)l * BATCH * nheads * 128 * V + ((size_t)sh * 128) * V + vs * 64;
    const int ti = w >> 1, vi = w & 1;
    f32x4 Sacc[2][2];
#pragma unroll
    for (int cj = 0; cj < 2; ++cj)
#pragma unroll
        for (int oj = 0; oj < 2; ++oj) Sacc[cj][oj] = (f32x4){0.f, 0.f, 0.f, 0.f};
    __syncthreads();
    for (int i = tid; i < 64 * SQ / 4; i += NTHR) ((LAS unsigned*)(lds + R_ST0))[i] = 0u;
    constexpr int NCORE = IMG_BYTES / 16;
    u32x4 pre[7], pre2[7]; f32x4 em1[2], em2[2];
    int pidx[6];
#pragma unroll
    for (int i = 0; i < 6; ++i) { const int pi_ = tid + i * NTHR; pidx[i] = pi_ < NCORE ? pi_ : NCORE - 1; }
    const int vt_t = ((tid >> 6) & 1) * 32 + (tid & 31), vt_q = (tid >> 7) * 2 + ((tid >> 5) & 1);
#define REC_FETCH(pre, em, chn) do { const unsigned char* im_ = img0 + (size_t)(chn) * IMG_BYTES; \
        _Pragma("unroll") for (int i = 0; i < 6; ++i) pre[i] = *(const u32x4*)(im_ + (size_t)pidx[i] * 16);     \
        pre[6] = *(const u32x4*)(vp + (size_t)((chn) * 64 + vt_t) * 1024 + vt_q * 8); \
        { const float* e_ = em0 + (size_t)((chn) + 1 < SEQ / 64 ? (chn) + 1 : (chn)) * 128; em[0] = *(const f32x4*)e_; em[1] = *(const f32x4*)(e_ + 16); } } while (0)
#define REC_STAGE(pre) do { _Pragma("unroll") for (int i = 0; i < 6; ++i) *(LAS u32x4*)(lds + pidx[i] * 16) = pre[i]; \
        { const unsigned wv_[4] = {pre[6].x, pre[6].y, pre[6].z, pre[6].w}; \
          _Pragma("unroll") for (int i = 0; i < 4; ++i) { *(LAS bf16_t*)(lds + R_VT + (vt_q * 8 + 2 * i) * SK + vt_t * 2) = (bf16_t)(wv_[i] & 0xffffu); *(LAS bf16_t*)(lds + R_VT + (vt_q * 8 + 2 * i + 1) * SK + vt_t * 2) = (bf16_t)(wv_[i] >> 16); } } } while (0)
    REC_FETCH(pre, em1, 0); REC_FETCH(pre2, em2, 1);
    for (int ch = 0; ch < SEQ / 64; ch += 2) {
#pragma unroll
      for (int half = 0; half < 2; ++half) {
        const int st_rd = half ? R_ST1 : R_ST0, st_wr = half ? R_ST0 : R_ST1;
        __syncthreads();
        f32x4 emn[2];
        if (half == 0) { REC_STAGE(pre); emn[0] = em1[0]; emn[1] = em1[1]; REC_FETCH(pre, em1, (ch + 2 < SEQ / 64 ? ch + 2 : SEQ / 64 - 1)); }
        else { REC_STAGE(pre2); emn[0] = em2[0]; emn[1] = em2[1]; REC_FETCH(pre2, em2, (ch + 3 < SEQ / 64 ? ch + 3 : SEQ / 64 - 1)); }
        __syncthreads();
        f32x4 oacc[2] = {(f32x4){0.f, 0.f, 0.f, 0.f}, (f32x4){0.f, 0.f, 0.f, 0.f}};
        __builtin_amdgcn_s_setprio(1);
#pragma unroll
        for (int kk = 0; kk < 4; ++kk) { const bf16x8_t qf = *(const LAS bf16x8_t*)(lds + R_QA + (ti * 16 + fr) * SQ + kk * 64 + fq * 16);
#pragma unroll
            for (int oj = 0; oj < 2; ++oj) { const bf16x8_t bb = *(const LAS bf16x8_t*)(lds + st_rd + ((2 * vi + oj) * 16 + fr) * SQ + kk * 64 + fq * 16); oacc[oj] = MFMA16(bb, qf, oacc[oj]); } }
        bf16x8_t vf[2][2];
#pragma unroll
        for (int oj = 0; oj < 2; ++oj)
#pragma unroll
            for (int kk = 0; kk < 2; ++kk) vf[oj][kk] = *(const LAS bf16x8_t*)(lds + R_VT + ((2 * vi + oj) * 16 + fr) * SK + kk * 64 + fq * 16);
#pragma unroll
        for (int kk = 0; kk < 2; ++kk) { const bf16x8_t a = *(const LAS bf16x8_t*)(lds + R_PP + (ti * 16 + fr) * SK + kk * 64 + fq * 16);
#pragma unroll
            for (int oj = 0; oj < 2; ++oj) oacc[oj] = MFMA16(vf[oj][kk], a, oacc[oj]); }
#pragma unroll
        for (int cj = 0; cj < 2; ++cj) { const int ct = 2 * ti + cj;
            const f32x4 dc = *(const LAS f32x4*)(lds + R_DEC + (ct * 16 + fq * 4) * 4);
#pragma unroll
            for (int oj = 0; oj < 2; ++oj) Sacc[cj][oj] = Sacc[cj][oj] * dc;
#pragma unroll
            for (int kk = 0; kk < 2; ++kk) { const bf16x8_t kf = *(const LAS bf16x8_t*)(lds + R_KBT + (ct * 16 + fr) * SK + kk * 64 + fq * 16);
#pragma unroll
                for (int oj = 0; oj < 2; ++oj) Sacc[cj][oj] = MFMA16(kf, vf[oj][kk], Sacc[cj][oj]); } }
        __builtin_amdgcn_s_setprio(0);
#pragma unroll
        for (int oj = 0; oj < 2; ++oj) *(f32x4*)(op + (size_t)((ch + half) * 64 + ti * 16 + fr) * D + (2 * vi + oj) * 16 + fq * 4) = oacc[oj];
        { const f32x4 q2 = oacc[0] * oacc[0] + oacc[1] * oacc[1]; float x = (q2[0] + q2[1]) + (q2[2] + q2[3]);
          x += __shfl_xor(x, 16); x += __shfl_xor(x, 32);
          if (fq == 0) ((LAS float*)(lds + R_OSQ))[((ch + half) * 64 + ti * 16 + fr) * 2 + vi] = x; }
#pragma unroll
        for (int cj = 0; cj < 2; ++cj)
#pragma unroll
            for (int oj = 0; oj < 2; ++oj) { u32x2 wv; wv.x = pk2(Sacc[cj][oj][0] * emn[cj][0], Sacc[cj][oj][1] * emn[cj][1]); wv.y = pk2(Sacc[cj][oj][2] * emn[cj][2], Sacc[cj][oj][3] * emn[cj][3]);
                *(LAS u32x2*)(lds + st_wr + ((2 * vi + oj) * 16 + fr) * SQ + ((2 * ti + cj) * 16 + fq * 4) * 2) = wv; }
      }
    }
#undef REC_FETCH
#undef REC_STAGE
#pragma unroll
    for (int cj = 0; cj < 2; ++cj)
#pragma unroll
        for (int oj = 0; oj < 2; ++oj)
#pragma unroll
            for (int j = 0; j < 4; ++j) sp[(size_t)((2 * ti + cj) * 16 + fq * 4 + j) * V + (2 * vi + oj) * 16 + fr] = Sacc[cj][oj][j];
    const int nsl = V / 64;
    float* xo = (float*)(ws + WS_XO) + (size_t)shg * 4 * SEQ;
    unsigned* ocnt = (unsigned*)(ws + WS_CTL) + CW_OCNT + (l * NSH + shg) * 64;
    unsigned* tmo = (unsigned*)(ws + WS_CTL) + CW_TMO;
    __syncthreads();
    { const f32x4 a = *(const LAS f32x4*)(lds + R_OSQ + tid * 32), bq = *(const LAS f32x4*)(lds + R_OSQ + tid * 32 + 16);
      float* slot = xo + (size_t)vs * SEQ + tid * 4;
      __hip_atomic_store(slot + 0, a[0] + a[1], __ATOMIC_RELAXED, __HIP_MEMORY_SCOPE_AGENT); __hip_atomic_store(slot + 1, a[2] + a[3], __ATOMIC_RELAXED, __HIP_MEMORY_SCOPE_AGENT);
      __hip_atomic_store(slot + 2, bq[0] + bq[1], __ATOMIC_RELAXED, __HIP_MEMORY_SCOPE_AGENT); __hip_atomic_store(slot + 3, bq[2] + bq[3], __ATOMIC_RELAXED, __HIP_MEMORY_SCOPE_AGENT); }
    asm volatile("s_waitcnt vmcnt(0)" ::: "memory");
    __syncthreads();
    if (w == 0) {
        if (lane == 0) __hip_atomic_fetch_add(ocnt, 1u, __ATOMIC_RELAXED, __HIP_MEMORY_SCOPE_AGENT);
        unsigned sp_ = 0u;
        while ((unsigned)__builtin_amdgcn_readfirstlane(__hip_atomic_load(ocnt, __ATOMIC_RELAXED, __HIP_MEMORY_SCOPE_AGENT)) < (unsigned)nsl) {
            __builtin_amdgcn_s_sleep(1);
            if ((++sp_ & 255u) == 0u) { if (__hip_atomic_load(tmo, __ATOMIC_RELAXED, __HIP_MEMORY_SCOPE_AGENT)) break; if (sp_ > (1u << 18)) { if (lane == 0) atomicAdd(tmo, 1u); break; } } }
        __builtin_amdgcn_fence(__ATOMIC_ACQUIRE, "agent"); }
    __syncthreads();
    { f32x4 qa, qb, qc, qd; const float* x0 = xo + tid * 4;
      ld_sc1_4x4(x0, x0 + SEQ, x0 + 2 * SEQ, x0 + 3 * SEQ, qa, qb, qc, qd);
      float s4[4];
#pragma unroll
      for (int j = 0; j < 4; ++j) s4[j] = (qa[j] + qb[j]) + (nsl > 2 ? qc[j] + qd[j] : 0.f);
      const float iv = gla ? (1.f / GV) : (1.f / HV);
      *(LAS f32x4*)(lds + R_ORS + tid * 16) = (f32x4){rsqrtf(s4[0] * iv + EPS), rsqrtf(s4[1] * iv + EPS), rsqrtf(s4[2] * iv + EPS), rsqrtf(s4[3] * iv + EPS)}; }
    __syncthreads();
    { const int c4 = (tid & 15) * 4, r0 = tid >> 4;
      const f32x4 gn4 = *(const f32x4*)((gla ? p.gln + l * GV : p.hgn + l * HV) + vs * 64 + c4);
      const bf16_t* gate = (const bf16_t*)(ws + (gla ? WS_RG : WS_GHG)) + (size_t)(b * SEQ) * 1024 + head * V + vs * 64 + c4;
      bf16_t* og = (bf16_t*)(ws + WS_OG) + (size_t)(b * SEQ) * D + (gla ? 1024 : 0) + head * V + vs * 64 + c4;
      const float* orow = op + c4;
#pragma nounroll
      for (int rb = 0; rb < SEQ; rb += 256) {
          f32x4 ov[8]; u32x2 gw[8];
#pragma unroll
          for (int i = 0; i < 8; ++i) { const int r = rb + i * 32 + r0; ov[i] = *(const f32x4*)(orow + (size_t)r * D); gw[i] = *(const u32x2*)(gate + (size_t)r * 1024); }
#pragma unroll
          for (int i = 0; i < 8; ++i) { const int r = rb + i * 32 + r0; const float rs = ((const LAS float*)(lds + R_ORS))[r];
              const float g0 = __uint_as_float(gw[i].x << 16), g1 = __uint_as_float(gw[i].x & 0xffff0000u), g2 = __uint_as_float(gw[i].y << 16), g3 = __uint_as_float(gw[i].y & 0xffff0000u);
              u32x2 wv; wv.x = pk2(ov[i][0] * rs * gn4[0] * g0, ov[i][1] * rs * gn4[1] * g1); wv.y = pk2(ov[i][2] * rs * gn4[2] * g2, ov[i][3] * rs * gn4[3] * g3);
              *(u32x2*)(og + (size_t)r * D) = wv; } } }
    __syncthreads();
}

template <int V, bool GLA> __device__ __forceinline__ void rec_sample_item(const P& p, unsigned char* ws, int l, LAS unsigned char* lds, int b, int head) {
    constexpr int nheads = GLA ? GH : HH, ldk = GLA ? GKW : HW, NV4 = V / 4, NCG = NTHR / NV4, CPG = 128 / NCG;
    const int tid = tidx(); const size_t row = (size_t)(MP + b);
    LAS float* DQ = (LAS float*)lds; LAS float* RED = (LAS float*)(lds + 2048);
    __syncthreads();
    if (tid < 128) {
        DQ[tid] = __expf(((const float*)(ws + (GLA ? WS_LOGA : WS_LOGF)))[row * ldk + head * 128 + tid]);
        DQ[128 + tid] = bf2f(((const bf16_t*)(ws + (GLA ? WS_KG : WS_KH)))[row * ldk + head * 128 + tid]);
        DQ[256 + tid] = bf2f(((const bf16_t*)(ws + (GLA ? WS_QG : WS_QH)))[row * ldk + head * 128 + tid]);
    }
    __syncthreads();
    const int v4 = tid % NV4, cg = tid / NV4;
    const u32x2 vw = *(const u32x2*)((const bf16_t*)(ws + (GLA ? WS_VG : WS_VH)) + row * 1024 + head * V + v4 * 4);
    const f32x4 vv = (f32x4){__uint_as_float(vw.x << 16), __uint_as_float(vw.x & 0xffff0000u), __uint_as_float(vw.y << 16), __uint_as_float(vw.y & 0xffff0000u)};
    const size_t sbase = ((size_t)l * DECB * nheads + (size_t)b * nheads + head) * 128 * V;
    const float* s0 = (GLA ? p.stg : p.sth) + sbase; float* so = p.out + (GLA ? OUT_GS : OUT_HS) + sbase;
    f32x4 oacc = (f32x4){0.f, 0.f, 0.f, 0.f};
    f32x4 sv[CPG];
#pragma unroll
    for (int i = 0; i < CPG; ++i) sv[i] = __builtin_nontemporal_load((const f32x4*)(s0 + (size_t)(cg * CPG + i) * V + v4 * 4));
#pragma unroll
    for (int i = 0; i < CPG; ++i) { const int cc = cg * CPG + i; const f32x4 sn = sv[i] * DQ[cc] + vv * DQ[128 + cc]; __builtin_nontemporal_store(sn, (f32x4*)(so + (size_t)cc * V + v4 * 4)); oacc += sn * DQ[256 + cc]; }
    *(LAS f32x4*)(RED + cg * V + v4 * 4) = oacc;
    __syncthreads();
    float s = 0.f;
    if (tid < V) {
#pragma unroll
        for (int g = 0; g < NCG; ++g) s += RED[g * V + tid]; }
    { float q = wave_sum(tid < V ? s * s : 0.f);
      __syncthreads();
      if ((tid & 63) == 0) DQ[384 + (tid >> 6)] = q;
      __syncthreads();
      float tot = 0.f;
#pragma unroll
      for (int k = 0; k < V / 64; ++k) tot += DQ[384 + k];
      if (tid < V) { const float rs = rsqrtf(tot * (1.f / V) + EPS);
          const float gn = (GLA ? p.gln + l * GV : p.hgn + l * HV)[tid];
          const float gt = bf2f(((const bf16_t*)(ws + (GLA ? WS_RG : WS_GHG)))[row * 1024 + head * V + tid]);
          ((bf16_t*)(ws + WS_OG))[row * D + (GLA ? 1024 : 0) + head * V + tid] = (bf16_t)pk2(s * rs * gn * gt, 0.f); } }
}
constexpr int REP_SST = 1, REP_LOOP = 1;
#ifndef LK_ITEMS
#define LK_ITEMS 0
#endif
__device__ __forceinline__ void phase_rec(const P& p, unsigned char* ws, int l, LAS unsigned char* lds, int wg, int nwg) {
    int lrank = wg, nloop = nwg, srank = wg, nstr = nwg;
    const bool split = nwg >= 16;
    if (split) { const int grp = wg >> 3, ngrp = (nwg + 7) >> 3, nlg = (ngrp + 1) >> 1;
        const int full_l = nlg * 8 - ((ngrp & 1) ? (ngrp * 8 - nwg) : 0), full_s = nwg - full_l;
        nloop = full_l; nstr = full_s; lrank = (grp >> 1) * 8 + (wg & 7); srank = (grp >> 1) * 8 + (wg & 7);
        if (grp & 1) lrank = 1 << 30; else srank = 1 << 30; }
    for (int rl = 0; rl < REP_LOOP; ++rl) for (int tk = lrank; tk < 128; tk += nloop) rec_loop_task(p, ws, l, lds, tk);
    const int nlk = split ? LK_ITEMS * nloop : 0;
    for (int rs = 0; rs < REP_SST; ++rs) {
    if (split) for (int it = lrank; it < nlk; it += nloop) rec_sample_item<HV, false>(p, ws, l, lds, it >> 3, it & 7);
    for (int it = nlk + srank; it < DECB * HH; it += nstr) rec_sample_item<HV, false>(p, ws, l, lds, it >> 3, it & 7);
    for (int it = srank; it < DECB * GH; it += nstr) rec_sample_item<GV, true>(p, ws, l, lds, it >> 2, it & 3); }
}


constexpr int SG32_LD = 36;
template <int MODE, int NST, class F>
__device__ __forceinline__ void sample_gemm32(const bf16_t* A, int lda, const bf16_t* Bt, int ldb, int N, const F& f, float* aux, LAS unsigned char* lds, int wg, int nwg) {
    const int tid = tidx(), lane = tid & 63, w = __builtin_amdgcn_readfirstlane(tid >> 6), fr = lane & 15, fq = lane >> 4;
    constexpr int Kw = NST * 32;
    const int nitems = (N / 32) * 4;
    LAS float* tile = (LAS float*)lds;
    for (int item = wg; item < nitems; item += nwg) {
        const int rb = item & 3, cb = item >> 2;
        const char* abase = (const char*)(A + (size_t)(rb * 32) * lda + w * Kw);
        const char* bbase = (const char*)(Bt + (size_t)(cb * 32) * ldb + w * Kw);
        unsigned aoff[2], boff[2];
#pragma unroll
        for (int t2 = 0; t2 < 2; ++t2) { aoff[t2] = (unsigned)((t2 * 16 + fr) * lda + fq * 8) * 2u; boff[t2] = (unsigned)((t2 * 16 + fr) * ldb + fq * 8) * 2u; }
        bf16x8_t av[NST][2], bv[NST][2];
#pragma unroll
        for (int st = 0; st < NST; ++st)
#pragma unroll
            for (int t2 = 0; t2 < 2; ++t2) { av[st][t2] = *(const bf16x8_t*)(abase + st * 64 + aoff[t2]); bv[st][t2] = *(const bf16x8_t*)(bbase + st * 64 + boff[t2]); }
        f32x4 acc[2][2];
#pragma unroll
        for (int mt = 0; mt < 2; ++mt)
#pragma unroll
            for (int nt = 0; nt < 2; ++nt) acc[mt][nt] = (f32x4){0.f, 0.f, 0.f, 0.f};
        __builtin_amdgcn_s_setprio(1);
#pragma unroll
        for (int st = 0; st < NST; ++st)
#pragma unroll
            for (int mt = 0; mt < 2; ++mt)
#pragma unroll
                for (int nt = 0; nt < 2; ++nt) acc[mt][nt] = MFMA16(bv[st][nt], av[st][mt], acc[mt][nt]);
        __builtin_amdgcn_s_setprio(0);
        __syncthreads();
        LAS float* tk = tile + w * (32 * SG32_LD);
#pragma unroll
        for (int mt = 0; mt < 2; ++mt)
#pragma unroll
            for (int nt = 0; nt < 2; ++nt) *(LAS f32x4*)(tk + (mt * 16 + fr) * SG32_LD + nt * 16 + fq * 4) = acc[mt][nt];
        __syncthreads();
        if (tid < 128) {
            const int r = tid >> 2, cq = (tid & 3) * 8;
            f32x4 x0 = *(const LAS f32x4*)(tile + r * SG32_LD + cq), x1 = *(const LAS f32x4*)(tile + r * SG32_LD + cq + 4);
#pragma unroll
            for (int q = 1; q < 8; ++q) { x0 += *(const LAS f32x4*)(tile + q * (32 * SG32_LD) + r * SG32_LD + cq); x1 += *(const LAS f32x4*)(tile + q * (32 * SG32_LD) + r * SG32_LD + cq + 4); }
            const float v[8] = {x0[0], x0[1], x0[2], x0[3], x1[0], x1[1], x1[2], x1[3]};
            const int row = MP + rb * 32 + r;
            if constexpr (MODE == 0) f.apply8(row, cb * 32 + cq, v, f.rowctx(row));
            else { float ssum = f.apply8s(row, cb * 32 + cq, v); ssum += __shfl_xor(ssum, 1); ssum += __shfl_xor(ssum, 2); if ((tid & 3) == 0) aux[(size_t)row * SSQW + cb] = ssum; }
        }
    }
    __syncthreads();
}

constexpr int SG64_LD = 68;
#ifndef SG64_SB
#define SG64_SB 2
#endif
static_assert(8 * 64 * SG64_LD * 4 <= LDS_BYTES - 2048, "sample GEMM (64x64) LDS tiles");
template <int MODE, int KSPLIT, class F>
__device__ __forceinline__ void sample_gemm64(const bf16_t* A, int lda, const bf16_t* Bt, int ldb, int N, int K, const F& f, float* aux, LAS unsigned char* lds, int wg, int nwg) {
    const int tid = tidx(), lane = tid & 63, w = __builtin_amdgcn_readfirstlane(tid >> 6), fr = lane & 15, fq = lane >> 4;
    const int Kc = K / KSPLIT, Kw = Kc / 8, nbatch = Kw / (32 * SG64_SB), nitems = 2 * (N / 64) * KSPLIT;
    LAS float* tile = (LAS float*)lds;
    for (int item = wg; item < nitems; item += nwg) {
        const int rb = item & 1, rest = item >> 1, ks = rest % KSPLIT, cb = rest / KSPLIT;
        const char* abase = (const char*)(A + (size_t)(rb * 64) * lda + ks * Kc + w * Kw);
        const char* bbase = (const char*)(Bt + (size_t)(cb * 64) * ldb + ks * Kc + w * Kw);
        unsigned aoff[4], boff[4];
#pragma unroll
        for (int t4 = 0; t4 < 4; ++t4) { aoff[t4] = (unsigned)((t4 * 16 + fr) * lda + fq * 8) * 2u; boff[t4] = (unsigned)((t4 * 16 + fr) * ldb + fq * 8) * 2u; }
        f32x4 acc[4][4];
#pragma unroll
        for (int mt = 0; mt < 4; ++mt)
#pragma unroll
            for (int nt = 0; nt < 4; ++nt) acc[mt][nt] = (f32x4){0.f, 0.f, 0.f, 0.f};
#pragma nounroll
        for (int b = 0; b < nbatch; ++b) {
            bf16x8_t av[SG64_SB][4], bv[SG64_SB][4];
            const char* ab_ = abase + b * (64 * SG64_SB); const char* bb_ = bbase + b * (64 * SG64_SB);
#pragma unroll
            for (int st = 0; st < SG64_SB; ++st)
#pragma unroll
                for (int t4 = 0; t4 < 4; ++t4) { av[st][t4] = *(const bf16x8_t*)(ab_ + st * 64 + aoff[t4]); bv[st][t4] = *(const bf16x8_t*)(bb_ + st * 64 + boff[t4]); }
#pragma unroll
            for (int st = 0; st < SG64_SB; ++st)
#pragma unroll
                for (int mt = 0; mt < 4; ++mt)
#pragma unroll
                    for (int nt = 0; nt < 4; ++nt) acc[mt][nt] = MFMA16(bv[st][nt], av[st][mt], acc[mt][nt]);
        }
        __syncthreads();
        LAS float* tk = tile + w * (64 * SG64_LD);
#pragma unroll
        for (int mt = 0; mt < 4; ++mt)
#pragma unroll
            for (int nt = 0; nt < 4; ++nt) *(LAS f32x4*)(tk + (mt * 16 + fr) * SG64_LD + nt * 16 + fq * 4) = acc[mt][nt];
        __syncthreads();
        const int r = tid >> 3, cq = (tid & 7) * 8;
        f32x4 x0 = *(const LAS f32x4*)(tile + r * SG64_LD + cq), x1 = *(const LAS f32x4*)(tile + r * SG64_LD + cq + 4);
#pragma unroll
        for (int q = 1; q < 8; ++q) { x0 += *(const LAS f32x4*)(tile + q * (64 * SG64_LD) + r * SG64_LD + cq); x1 += *(const LAS f32x4*)(tile + q * (64 * SG64_LD) + r * SG64_LD + cq + 4); }
        const float v[8] = {x0[0], x0[1], x0[2], x0[3], x1[0], x1[1], x1[2], x1[3]};
        const int row = MP + rb * 64 + r, col = cb * 64 + cq;
        if constexpr (MODE == 0) f.apply8(row, col, v, f.rowctx(row));
        else { float* dst = aux + ((size_t)ks * DECB + (row - MP)) * N + col; *(f32x4*)dst = x0; *(f32x4*)(dst + 4) = x1; }
    }
    __syncthreads();
}

#define XB_TMO      128
#define XB_XCNT(j)  (256  + 64 * (j))
#define XB_XSUB(j)  (1280 + 64 * (j))
#define XB_XGEN(j)  (2304 + 64 * (j))
#define XB_TOP      3328
#define XB_TOPGEN   3392
#define XCD_BAR_WORDS 3456
#define XB_SPIN_CAP (1u << 18)
__device__ __forceinline__ unsigned xb_ld(unsigned* p)              { return __hip_atomic_load(p, __ATOMIC_RELAXED, __HIP_MEMORY_SCOPE_AGENT); }
__device__ __forceinline__ unsigned xb_add(unsigned* p, unsigned v) { return __hip_atomic_fetch_add(p, v, __ATOMIC_RELAXED, __HIP_MEMORY_SCOPE_AGENT); }
__device__ __forceinline__ unsigned xb_xcc_id() { return (unsigned)__builtin_amdgcn_s_getreg((3 << 11) | 20) & 0xFu; }
#define XB_SPIN(cond, bar) do { unsigned _sp = 0; while (cond) { __builtin_amdgcn_s_sleep(1); \
    if ((++_sp & 255u) == 0u) { if (xb_ld(&(bar)[XB_TMO])) break; if (_sp > XB_SPIN_CAP) { atomicAdd(&(bar)[XB_TMO], 1u); break; } } } } while (0)
struct XcdBarrier { unsigned* bar; unsigned x; volatile LAS unsigned* st; };
__device__ __forceinline__ XcdBarrier xcd_barrier_post(unsigned* bar, volatile LAS unsigned* st) {
    XcdBarrier b; b.bar = bar; b.x = xb_xcc_id(); b.st = st;
    if (threadIdx.x == 0) (void)xb_add(&bar[XB_XCNT(b.x)], 1u);
    return b;
}
__device__ __forceinline__ void xcd_barrier_complete(unsigned* bar, unsigned x, unsigned& nloc, unsigned& nx) {
    const unsigned G = gridDim.x * gridDim.y * gridDim.z;
    unsigned sum, cnt, mine, sp = 0u;
    for (;;) {
        sum = 0u; cnt = 0u; mine = 0u;
#pragma unroll
        for (unsigned j = 0; j < 16; ++j) { const unsigned c = xb_ld(&bar[XB_XCNT(j)]); sum += c; cnt += (c > 0u) ? 1u : 0u; mine = (j == x) ? c : mine; }
        if (sum == G) break;
        __builtin_amdgcn_s_sleep(1);
        if ((++sp & 255u) == 0u) { if (xb_ld(&bar[XB_TMO])) break; if (sp > XB_SPIN_CAP) { atomicAdd(&bar[XB_TMO], 1u); break; } }
    }
    nloc = mine > 0u ? mine : 1u; nx = cnt > 0u ? cnt : 1u;
}
__device__ __forceinline__ void xcd_barrier(const XcdBarrier& b) {
    asm volatile("s_waitcnt vmcnt(0)" ::: "memory");
    __syncthreads();
    if (threadIdx.x == 0) {
        unsigned* bar = b.bar;
        __builtin_amdgcn_s_waitcnt(0);
        unsigned nloc = b.st[0], nx = b.st[1];
        if (nloc == 0u) { xcd_barrier_complete(bar, b.x, nloc, nx); b.st[0] = nloc; b.st[1] = nx; }
        const unsigned old = xb_add(&bar[XB_XSUB(b.x)], 1u);
        const unsigned gen = old / nloc;
        if (old + 1u == (gen + 1u) * nloc) {
            __builtin_amdgcn_fence(__ATOMIC_RELEASE, "agent");
            asm volatile("s_waitcnt vmcnt(0)" ::: "memory");
            const unsigned og = xb_add(&bar[XB_TOP], 1u);
            const unsigned tg = og / nx;
            if (og + 1u == (tg + 1u) * nx) xb_add(&bar[XB_TOPGEN], 1u);
            else XB_SPIN(xb_ld(&bar[XB_TOPGEN]) == tg, bar);
            __builtin_amdgcn_fence(__ATOMIC_ACQUIRE, "agent");
            xb_add(&bar[XB_XGEN(b.x)], 1u);
            asm volatile("s_waitcnt vmcnt(0)" ::: "memory");
        } else {
            XB_SPIN(xb_ld(&bar[XB_XGEN(b.x)]) == gen, bar);
            __builtin_amdgcn_fence(__ATOMIC_ACQUIRE, "agent");
            asm volatile("s_waitcnt vmcnt(0)" ::: "memory");
        }
    }
    __syncthreads();
}


constexpr int LDS_P_OFF = LDS_BYTES - 2048 + 256;
constexpr int RST_OFF = 131072;
static_assert(RST_OFF + 4 * 256 * 4 + 16 <= LDS_BYTES - 2048, "rstd table");
__device__ __forceinline__ const float* lds_ptr(LAS unsigned char* lds, int i) {
    const unsigned lo = *(LAS const unsigned*)(lds + LDS_P_OFF + 8 * i), hi = *(LAS const unsigned*)(lds + LDS_P_OFF + 8 * i + 4);
    return (const float*)(const __attribute__((address_space(1))) float*)(((unsigned long long)(unsigned)__builtin_amdgcn_readfirstlane((int)hi) << 32) | (unsigned)__builtin_amdgcn_readfirstlane((int)lo));
}
__device__ __forceinline__ P load_P(LAS unsigned char* lds) {
    P p;
    p.xp = lds_ptr(lds, 0); p.xs = lds_ptr(lds, 1); p.pp = lds_ptr(lds, 2); p.ps = lds_ptr(lds, 3); p.sth = lds_ptr(lds, 4); p.stg = lds_ptr(lds, 5);
    p.n_pre_mix = lds_ptr(lds, 6); p.n_post_mix = lds_ptr(lds, 7); p.n_pre_ffn = lds_ptr(lds, 8); p.n_post_ffn = lds_ptr(lds, 9); p.w_in = lds_ptr(lds, 10); p.lbp = lds_ptr(lds, 11);
    p.hgn = lds_ptr(lds, 12); p.w_hup = lds_ptr(lds, 13); p.wgg = lds_ptr(lds, 14); p.bgg = lds_ptr(lds, 15); p.gln = lds_ptr(lds, 16); p.w_gup = lds_ptr(lds, 17);
    p.w_out = lds_ptr(lds, 18); p.w_ff1 = lds_ptr(lds, 19); p.w_ff2 = lds_ptr(lds, 20); p.w_ple = lds_ptr(lds, 21); p.w_plg = lds_ptr(lds, 22);
    p.out = (float*)lds_ptr(lds, 23); p.ws = (unsigned char*)lds_ptr(lds, 24);
    return p;
}

constexpr int LDSCTL_OFF = LDS_BYTES - 2048;
constexpr int CW_BAR = 1024;
static_assert(CW_TMO == CW_BAR + XB_TMO, "timeout word index");
constexpr int REP_PRO = 1, REP_GEMM = 1, REP_REC = 1, REP_ONORM = 1, REP_BAR = 1, REP_GS = 1, REP_POST = 1, REP_P7 = 1, REP_PREP = 1;
constexpr int REP_G[8] = {1, 1, 1, 1, 1, 1, 1, 1};
struct Args { P p; int ph_lo, ph_hi; };
__global__ void __launch_bounds__(NTHR, 2) mega(const Args a) {
    extern __shared__ __attribute__((aligned(16))) unsigned char lds_raw[];
    LAS unsigned char* lds = (LAS unsigned char*)lds_raw;
    const int wg0 = blockIdx.x, nwg0 = gridDim.x, tid = threadIdx.x;
    for (int u = tid; u < (LDS_BYTES - LDSCTL_OFF) / 4; u += NTHR) ((LAS unsigned*)(lds + LDSCTL_OFF))[u] = 0u;
    __syncthreads();
    if (tid == 0) { const unsigned long long* src = (const unsigned long long*)&a.p;
#pragma unroll
        for (int i = 0; i < 25; ++i) *(LAS unsigned long long*)(lds + LDS_P_OFF + 8 * i) = src[i]; }
    __syncthreads();
    unsigned char* const ws0 = (unsigned char*)lds_ptr(lds, 24);
    XcdBarrier bar = xcd_barrier_post((unsigned*)(ws0 + WS_CTL) + CW_BAR, (volatile LAS unsigned*)(lds + LDSCTL_OFF + 32));
    const int lo = a.ph_lo, hi = a.ph_hi; int ph = 0;
#define PH_BEGIN if (ph >= lo && ph < hi) { unsigned long long wsi_ = (unsigned long long)ws0; int l = l0, wg = wg0, nwg = nwg0; asm volatile("" : "+s"(wsi_), "+s"(l), "+s"(wg), "+s"(nwg) :: "memory"); unsigned char* ws = (unsigned char*)(__attribute__((address_space(1))) unsigned char*)wsi_; const P p = load_P(lds); const int gtid = wg * NTHR + tidx(), gthreads = nwg * NTHR; (void)gtid; (void)gthreads;
#define PH_END } if (ph >= lo && ph + 1 < hi) for (int rb = 0; rb < REP_BAR; ++rb) xcd_barrier(bar); ++ph;
#define PH_END_NOBAR } ++ph;

    int l0 = 0;
    PH_BEGIN (void)l; for (int rep = 0; rep < REP_PRO; ++rep) phase_prologue(p, ws, lds, wg, nwg); PH_END
    PH_BEGIN (void)l;
    { int Kp = PLE; asm volatile("" : "+s"(Kp));
      pg8::Gemm g{(const bf16_t*)(ws + WS_PBF), (const bf16_t*)(ws + WS_WPLE), DEPTH * MP, DEPTH * D, Kp, PLE, PLE}; DiagOrder S{nwg, wg};
      EpiA<FPeD> E{FPeD{(bf16_t*)(ws + WS_PE)}};
      for (int rgp = 0; rgp < REP_G[0]; ++rgp) pg8::gemm_phase<EpiA<FPeD>, DiagOrder, true, true>(lds, g, S, E); }
    for (int l = 0; l < DEPTH; ++l) {
        FPe f{(bf16_t*)(ws + WS_PE) + (size_t)l * MR * D};
        sample_gemm32<0, PLE / 256>((const bf16_t*)(ws + WS_PBF) + (size_t)DEPTH * MP * PLE + (size_t)l * DECB * PLE, PLE, (const bf16_t*)(ws + WS_WPLE) + (size_t)l * D * PLE, PLE, D, f, (float*)nullptr, lds, wg, nwg);
    }
    PH_END_NOBAR
    for (l0 = 0; l0 < DEPTH; ++l0) {
#define HBF_CUR ((bf16_t*)(ws + ((l & 1) ? WS_HBF2 : WS_HBF)))
#define HBF_NXT ((bf16_t*)(ws + ((l & 1) ? WS_HBF : WS_HBF2)))
        PH_BEGIN
        for (int rep = 0; rep < REP_GEMM; ++rep) {
        const bf16_t* A = HBF_CUR; const bf16_t* Wt = (const bf16_t*)(ws + WS_WIN) + (size_t)l * NZ * D;
        pg8::Gemm g{A, Wt, MR, NZ, D, D, D}; pg8::StaticOrder S; S.init(MR, NZ, nwg, wg);
        FIn f{(const float*)(ws + WS_SSQ), (const float*)(ws + WS_LBS) + l * HW, p.bgg + l * GKW, ws, (const LAS float*)(lds + RST_OFF), -1, -1, -1};
        {
            { pg8::Unit u_;
#pragma nounroll
              for (int i = 0; S.next(i, u_); ++i) { if (u_.pm == f.pm0 || u_.pm == f.pm1 || u_.pm == f.pm2) continue; if (f.pm0 < 0) f.pm0 = u_.pm; else if (f.pm1 < 0) f.pm1 = u_.pm; else if (f.pm2 < 0) f.pm2 = u_.pm; } }
            const int t_ = tidx(); LAS float* tb = (LAS float*)(lds + RST_OFF);
            if (t_ < 256) { if (f.pm0 >= 0) tb[t_] = f.rowctx_g(f.pm0 * 256 + t_); if (f.pm1 >= 0) tb[256 + t_] = f.rowctx_g(f.pm1 * 256 + t_); if (f.pm2 >= 0) tb[512 + t_] = f.rowctx_g(f.pm2 * 256 + t_); }
            __syncthreads(); }
        EpiA<FIn> E{f};
        for (int rgp = 0; rgp < REP_G[1]; ++rgp) pg8::gemm_phase<EpiA<FIn>, pg8::StaticOrder, true, true>(lds, g, S, E);
        }
        PH_END
        PH_BEGIN for (int rep = 0; rep < REP_PREP; ++rep) { for (int tkp = wg; tkp < NSH * 32; tkp += nwg) rec_prep_task(ws, lds, tkp); __syncthreads(); } PH_END
        PH_BEGIN for (int rep = 0; rep < REP_REC; ++rep) phase_rec(p, ws, l, lds, wg, nwg); PH_END
        PH_BEGIN
        for (int rep = 0; rep < REP_GEMM; ++rep) {
        { const bf16_t* A = (const bf16_t*)(ws + WS_OG); const bf16_t* Wt = (const bf16_t*)(ws + WS_WUH) + (size_t)l * D * HW;
          pg8::Gemm g{A, Wt, MP, D, HW, D, HW}; pg8::StaticOrder S; S.init(MP, D, nwg, wg);
          EpiAP<FUp1> E{FUp1{(const bf16_t*)(ws + WS_MH), (bf16_t*)(ws + WS_T4)}};
          for (int rgp = 0; rgp < REP_G[2]; ++rgp) pg8::gemm_phase<EpiAP<FUp1>, pg8::StaticOrder, true, true>(lds, g, S, E);
          for (int rgs = 0; rgs < REP_GS; ++rgs) sample_gemm32<0, HW / 256>(A + (size_t)MP * D, D, Wt, HW, D, E.f, (float*)nullptr, lds, wg, nwg); }
        asm volatile("s_waitcnt vmcnt(0)" ::: "memory");
        { const bf16_t* A = (const bf16_t*)(ws + WS_OG) + 1024; const bf16_t* Wt = (const bf16_t*)(ws + WS_WUG) + (size_t)l * D * GVW;
          pg8::Gemm g{A, Wt, MP, D, GVW, D, GVW}; pg8::StaticOrder S; S.init(MP, D, nwg, wg);
          EpiAP<FUp2> E{FUp2{(const bf16_t*)(ws + WS_MG), (const bf16_t*)(ws + WS_T4), (bf16_t*)(ws + WS_MRG)}};
          for (int rgp = 0; rgp < REP_G[3]; ++rgp) pg8::gemm_phase<EpiAP<FUp2>, pg8::StaticOrder, true, true>(lds, g, S, E);
          for (int rgs = 0; rgs < REP_GS; ++rgs) sample_gemm32<0, GVW / 256>(A + (size_t)MP * D, D, Wt, GVW, D, E.f, (float*)nullptr, lds, wg, nwg); }
        }
        PH_END
        PH_BEGIN
        for (int rep = 0; rep < REP_GEMM; ++rep)
        { const bf16_t* A = (const bf16_t*)(ws + WS_MRG); const bf16_t* Wt = (const bf16_t*)(ws + WS_WOUT) + (size_t)l * D * D;
          pg8::Gemm g{A, Wt, MP, D, D, D, D}; pg8::StaticOrder S; S.init(MP, D, nwg, wg);
          EpiPost4 E{HBF_CUR, p.n_post_mix + l * D, (bf16_t*)(ws + WS_T4), (float*)(ws + WS_CTL) + CW_SSQ2, (float*)(ws + WS_CTL) + CW_X4, (unsigned*)(ws + WS_CTL) + CW_X4CNT + l * 32 * 64, (unsigned*)(ws + WS_CTL) + CW_BAR + XB_TMO};
          pg8::gemm_phase<EpiPost4, pg8::StaticOrder, true, true>(lds, g, S, E);
          for (int rgs = 0; rgs < REP_GS; ++rgs) sample_gemm32<0, D / 256>(A + (size_t)MP * D, D, Wt, D, D, FPartS{(float*)(ws + WS_PART4)}, (float*)nullptr, lds, wg, nwg); }
        PH_END
        PH_BEGIN for (int rep = 0; rep < REP_POST; ++rep) thin_post<0>(ws, lds, HBF_CUR, p.n_post_mix + l * D, p.n_pre_ffn + l * D, nullptr, nullptr, wg, nwg); PH_END
        PH_BEGIN
        for (int rep = 0; rep < REP_GEMM; ++rep)
        { const bf16_t* A = (const bf16_t*)(ws + WS_T4); const bf16_t* Wt = (const bf16_t*)(ws + WS_WFF1) + (size_t)l * DFF * D;
          pg8::Gemm g{A, Wt, MP, DFF, D, D, D}; pg8::StaticOrder S; S.init(MP, DFF, nwg, wg);
          FRelu2 f{(bf16_t*)(ws + WS_U), (const float*)(ws + WS_CTL) + CW_SSQ2, (const LAS float*)(lds + RST_OFF), -1, -1, -1, -1};
          { { pg8::Unit u_;
#pragma nounroll
              for (int i = 0; S.next(i, u_); ++i) { if (u_.pm == f.pm0 || u_.pm == f.pm1 || u_.pm == f.pm2 || u_.pm == f.pm3) continue; if (f.pm0 < 0) f.pm0 = u_.pm; else if (f.pm1 < 0) f.pm1 = u_.pm; else if (f.pm2 < 0) f.pm2 = u_.pm; else if (f.pm3 < 0) f.pm3 = u_.pm; } }
            const int t_ = tidx(); LAS float* tb = (LAS float*)(lds + RST_OFF);
            if (t_ < 256) { if (f.pm0 >= 0) tb[t_] = f.rowctx_g(f.pm0 * 256 + t_); if (f.pm1 >= 0) tb[256 + t_] = f.rowctx_g(f.pm1 * 256 + t_); if (f.pm2 >= 0) tb[512 + t_] = f.rowctx_g(f.pm2 * 256 + t_); if (f.pm3 >= 0) tb[768 + t_] = f.rowctx_g(f.pm3 * 256 + t_); }
            __syncthreads(); }
          EpiA<FRelu2> E{f};
          for (int rgp = 0; rgp < REP_G[5]; ++rgp) pg8::gemm_phase<EpiA<FRelu2>, pg8::StaticOrder, true, true>(lds, g, S, E);
          for (int rgs = 0; rgs < REP_GS; ++rgs) sample_gemm64<0, 1>(A + (size_t)MP * D, D, Wt, D, DFF, D, E.f, (float*)nullptr, lds, wg, nwg); }
        PH_END
        PH_BEGIN
        for (int rep = 0; rep < REP_GEMM; ++rep)
        { const bf16_t* A = (const bf16_t*)(ws + WS_U); const bf16_t* Wt = (const bf16_t*)(ws + WS_WFF2) + (size_t)l * D * DFF;
          pg8::Gemm g{A, Wt, MP, D, DFF, DFF, DFF}; pg8::StaticOrder S; S.init(MP, D, nwg, wg);
          EpiPost6 E{(const bf16_t*)(ws + WS_T4), p.n_post_ffn + l * D, (bf16_t*)(ws + WS_HBF3),
                     (float*)(ws + WS_CTL) + CW_X6, (unsigned*)(ws + WS_CTL) + CW_X6CNT + l * 32 * 64, (unsigned*)(ws + WS_CTL) + CW_BAR + XB_TMO};
          pg8::gemm_phase<EpiPost6, pg8::StaticOrder, true, true>(lds, g, S, E);
          for (int rgs = 0; rgs < REP_GS; ++rgs) sample_gemm64<2, 4>(A + (size_t)MP * DFF, DFF, Wt, DFF, D, DFF, FStoreBf{nullptr}, (float*)(ws + WS_PART6), lds, wg, nwg); }
        PH_END
        PH_BEGIN for (int rep = 0; rep < REP_POST; ++rep) thin_post<1>(ws, lds, HBF_CUR, p.n_post_mix + l * D, nullptr, p.n_post_ffn + l * D, (bf16_t*)(ws + WS_HBF3), wg, nwg); PH_END
        PH_BEGIN
        for (int rep = 0; rep < REP_P7; ++rep)
        { const bf16_t* A = (const bf16_t*)(ws + WS_HBF3); const bf16_t* Wt = (const bf16_t*)(ws + WS_WPLG) + (size_t)l * D * D;
          pg8::Gemm g{A, Wt, MP, D, D, D, D}; pg8::StaticOrder S; S.init(MP, D, nwg, wg);
          EpiPle E{FPle{(const bf16_t*)(ws + WS_HBF3), l == DEPTH - 1 ? p.out : (float*)nullptr, HBF_NXT, (const bf16_t*)(ws + WS_PE) + (size_t)l * MR * D}, (float*)(ws + WS_SSQ)};
          pg8::gemm_phase<EpiPle, pg8::StaticOrder, true, true>(lds, g, S, E);
          sample_gemm32<1, D / 256>(A + (size_t)MP * D, D, Wt, D, D, E.f, (float*)(ws + WS_SSQ), lds, wg, nwg); }
        PH_END
    }
#undef PH_BEGIN
#undef PH_END
#undef PH_END_NOBAR
}

#ifndef MK_PER_PHASE
#define MK_PER_PHASE 0
#endif
extern "C" void kernel_launch(void* const* d_in, const int* in_sizes, int n_in, void* d_out, int out_size, void* d_ws, size_t ws_size, hipStream_t stream) {
    static int grid = 0;
    if (grid == 0) {
        if (n_in != 23 || ws_size < WS_END) { fprintf(stderr, "kernel_launch: need 23 inputs and %zu bytes of workspace; got %d inputs, %zu bytes\n", (size_t)WS_END, n_in, ws_size); grid = -1; return; }
        int dev = 0, cus = 0, per_cu = 0;
        if (hipGetDevice(&dev) != hipSuccess || hipDeviceGetAttribute(&cus, hipDeviceAttributeMultiprocessorCount, dev) != hipSuccess) { fprintf(stderr, "kernel_launch: device query failed\n"); grid = -1; return; }
        if (hipFuncSetAttribute((const void*)mega, hipFuncAttributeMaxDynamicSharedMemorySize, LDS_BYTES) != hipSuccess) { fprintf(stderr, "kernel_launch: hipFuncSetAttribute failed\n"); grid = -1; return; }
        if (hipOccupancyMaxActiveBlocksPerMultiprocessor(&per_cu, (const void*)mega, NTHR, LDS_BYTES) != hipSuccess || per_cu < 1) { fprintf(stderr, "kernel_launch: occupancy query reports %d blocks per CU\n", per_cu); (void)hipGetLastError(); per_cu = 1; }
        grid = cus;
    }
    if (grid < 0) return;
    (void)hipMemsetAsync((char*)d_ws + WS_CTL, 0, CTL_BYTES, stream);
    Args a{};
    const float** pf = (const float**)&a.p;
    for (int i = 0; i < 23; ++i) pf[i] = (const float*)d_in[i];
    a.p.out = (float*)d_out; a.p.ws = (unsigned char*)d_ws;
    constexpr int NPH = 2 + DEPTH * 10;
#if MK_PER_PHASE
    for (int k = 0; k < NPH; ++k) { a.ph_lo = k; a.ph_hi = k + 1; hipLaunchKernelGGL(mega, dim3(grid), dim3(NTHR), LDS_BYTES, stream, a); }
#else
    a.ph_lo = 0; a.ph_hi = NPH;
    hipLaunchKernelGGL(mega, dim3(grid), dim3(NTHR), LDS_BYTES, stream, a);
#endif
}
```

```cpp
#include <hip/hip_runtime.h>
#include <cstdio>
#include <cstdint>

__device__ __forceinline__ int tidx() { int t = threadIdx.x; asm volatile("" : "+v"(t)); return t; }

namespace pg8 {
#define PG8_LAS __attribute__((address_space(3)))
typedef unsigned short bf16_t;
typedef short bf16x8 __attribute__((ext_vector_type(8)));
typedef float f32x4 __attribute__((ext_vector_type(4)));
typedef unsigned u32x4 __attribute__((ext_vector_type(4)));
constexpr int BM = 256, BK = 64, HALF = 128, HTB = HALF * BK * 2, STAGE_BYTES = 8 * HTB, NXCD = 8, WGM = 8;

__host__ __device__ __forceinline__ int lds_byte(int r, int c) { const int st = (r >> 4) * 2 + (c >> 5), rr = r & 15, cc = c & 31, ob = rr * 64 + cc * 2; return st * 1024 + (ob ^ (((ob >> 9) & 1) << 5)); }
__host__ __device__ __forceinline__ void stage_rc(int b, int& R, int& C) { const int st = b / 1024, sb = b % 1024, swz = sb ^ (((sb >> 9) & 1) << 5); R = (st >> 1) * 16 + swz / 64; C = (st & 1) * 32 + (swz % 64) / 2; }
__host__ __device__ __forceinline__ int perm32(int rho) { const int n = rho >> 4, i = rho & 15; return 8 * (i >> 2) + 4 * n + (i & 3); }

struct Unit { int pm, pn; };
struct Gemm { const bf16_t* A; const bf16_t* Bt; int M, N, K, lda, ldb; };

struct StaticOrder {
    int nM, nN, nwg, G, c;
    __host__ __device__ __forceinline__ void init(int M, int N, int G_, int c_) { nM = M / BM; nN = N / BM; nwg = nM * nN; G = G_; c = c_; }
    __host__ __device__ __forceinline__ bool next(int i, Unit& u) const {
        const long L = (long)i * G + c; if (L >= nwg) return false;
        int wgid = (int)L; { const int q = nwg / NXCD, r = nwg % NXCD, xcd = wgid % NXCD, off = wgid / NXCD; wgid = (xcd < r ? xcd * (q + 1) : r * (q + 1) + (xcd - r) * q) + off; }
        const int nig = WGM * nN, gid = wgid / nig, fm = gid * WGM, gsz = (nM - fm) < WGM ? (nM - fm) : WGM;
        u.pm = fm + ((wgid % nig) % gsz); u.pn = (wgid % nig) / gsz; return true;
    }
    __device__ __forceinline__ void a_ready(const Unit&) const {}
    __device__ __forceinline__ void done(const Unit&) const {}
};

typedef float f32x2_t __attribute__((ext_vector_type(2)));
typedef __bf16 bf16x2_t __attribute__((ext_vector_type(2)));
__device__ __forceinline__ unsigned cvt_pk_bf16(float lo, float hi) { return __builtin_bit_cast(unsigned, __builtin_convertvector((f32x2_t){lo, hi}, bf16x2_t)); }

template <class Epi, class Sched, bool ALIGN_EPI = false, bool SP2 = false>
__device__ __forceinline__ void gemm_phase(PG8_LAS unsigned char* lds, const Gemm g, const Sched& S, const Epi& E) {
    const int tid = tidx();
    const int wid = __builtin_amdgcn_readfirstlane(tid >> 6), lane = tid & 63, wr = wid >> 2, wc = wid & 3, fr = lane & 15, fq = lane >> 4;
    const int K = g.K, nt = K / BK;
    unsigned voffA[2], voffB[2];
#pragma unroll
    for (int i = 0; i < 2; ++i) { int R, C; stage_rc(tid * 16 + i * 8192, R, C); const int Rb = Epi::PERM ? ((R & ~31) + perm32(R & 31)) : R;
        voffA[i] = (unsigned)(R * g.lda + C) * 2u; voffB[i] = (unsigned)(Rb * g.ldb + C) * 2u; }
    const size_t kstep = (size_t)(BK * 2);
    const size_t hstepA = (size_t)HALF * g.lda * 2, hstepB = (size_t)HALF * g.ldb * 2;
    const size_t tstepA = 2 * hstepA, tstepB = 2 * hstepB;
    const unsigned ldsw = (unsigned)wid * 1024u;
    const int aoff = lds_byte(wr * 64 + fr, fq * 8), boff = lds_byte(wc * 32 + fr, fq * 8);
#define PG8_SA(b, h) (((b) * 2 + (h)) * HTB)
#define PG8_SB(b, h) ((4 + (b) * 2 + (h)) * HTB)
#define PG8_STAGE(bufoff, gbase, voff) do { _Pragma("unroll") for (int _i = 0; _i < 2; ++_i) \
        __builtin_amdgcn_global_load_lds((const unsigned*)((const char*)(gbase) + (voff)[_i]), (PG8_LAS unsigned*)(lds + (bufoff) + ldsw + _i * 8192), 16, 0, 0); } while (0)
#define PG8_LDA(dst, b, h) do { _Pragma("unroll") for (int m = 0; m < 4; ++m) _Pragma("unroll") for (int k = 0; k < 2; ++k) dst[m][k] = *(const PG8_LAS bf16x8*)(lds + PG8_SA(b, h) + aoff + m * 2048 + k * 1024); } while (0)
#define PG8_LDB(dst, b, h) do { _Pragma("unroll") for (int n = 0; n < 2; ++n) _Pragma("unroll") for (int k = 0; k < 2; ++k) dst[n][k] = *(const PG8_LAS bf16x8*)(lds + PG8_SB(b, h) + boff + n * 2048 + k * 1024); } while (0)
#define PG8_MMA(ai, bj, At, Bt) do { __builtin_amdgcn_s_setprio(1); _Pragma("unroll") for (int m = 0; m < 4; ++m) _Pragma("unroll") for (int n = 0; n < 2; ++n) _Pragma("unroll") for (int k = 0; k < 2; ++k) \
        acc[ai][bj][m][n] = __builtin_amdgcn_mfma_f32_16x16x32_bf16(Bt[n][k], At[m][k], acc[ai][bj][m][n], 0, 0, 0); __builtin_amdgcn_s_setprio(0); } while (0)
#define PG8_WAIT_V(n) asm volatile("s_waitcnt vmcnt(" #n ")" ::: "memory")
#define PG8_WAIT_L(n) asm volatile("s_waitcnt lgkmcnt(" #n ")" ::: "memory")
#define PG8_BAR __builtin_amdgcn_s_barrier()
#define PG8_SCHED __builtin_amdgcn_sched_barrier(0)
    Unit cur, nxt; int ui = 0;
    if (!S.next(0, cur)) return;
    f32x4 acc[2][2][4][2];
#pragma unroll
    for (int a = 0; a < 2; ++a)
#pragma unroll
        for (int b = 0; b < 2; ++b)
#pragma unroll
            for (int m = 0; m < 4; ++m)
#pragma unroll
                for (int n = 0; n < 2; ++n) acc[a][b][m][n] = (f32x4){0.f, 0.f, 0.f, 0.f};
    bf16x8 At[4][2], B0[2][2], B1[2][2];
    const char* cA = (const char*)g.A + (size_t)cur.pm * tstepA; const char* cB = (const char*)g.Bt + (size_t)cur.pn * tstepB;
    S.a_ready(cur);
    if constexpr (SP2) {
        PG8_STAGE(PG8_SB(0, 0), cB, voffB); PG8_STAGE(PG8_SB(0, 1), cB + hstepB, voffB); PG8_STAGE(PG8_SA(0, 0), cA, voffA); PG8_STAGE(PG8_SA(0, 1), cA + hstepA, voffA);
        if (wr == 1) PG8_BAR;
        PG8_WAIT_V(2); PG8_BAR;
        PG8_STAGE(PG8_SB(1, 0), cB + kstep, voffB); PG8_STAGE(PG8_SA(1, 0), cA + kstep, voffA); PG8_STAGE(PG8_SB(1, 1), cB + hstepB + kstep, voffB);
        PG8_WAIT_V(6); PG8_BAR;
    } else {
        PG8_STAGE(PG8_SB(0, 0), cB, voffB); PG8_STAGE(PG8_SA(0, 0), cA, voffA); PG8_STAGE(PG8_SB(0, 1), cB + hstepB, voffB); PG8_STAGE(PG8_SA(0, 1), cA + hstepA, voffA);
        if (wr == 1) PG8_BAR;
        PG8_WAIT_V(4); PG8_BAR;
        PG8_STAGE(PG8_SB(1, 0), cB + kstep, voffB); PG8_STAGE(PG8_SA(1, 0), cA + kstep, voffA); PG8_STAGE(PG8_SB(1, 1), cB + hstepB + kstep, voffB);
        PG8_WAIT_V(6); PG8_BAR;
    }
    for (;;) {
        const bool has_next = S.next(ui + 1, nxt);
        const char* nA = has_next ? (const char*)g.A + (size_t)nxt.pm * tstepA : cA; const char* nB = has_next ? (const char*)g.Bt + (size_t)nxt.pn * tstepB : cB;
        for (int t = 0; t < nt; t += 2) {
            const bool last = (t == nt - 2);
            const char* a1 = cA + (size_t)(t + 1) * kstep;
            const char* a2 = last ? nA : cA + (size_t)(t + 2) * kstep; const char* b2 = last ? nB : cB + (size_t)(t + 2) * kstep;
            const char* a3 = a2 + kstep; const char* b3 = b2 + kstep;
            if (last && has_next) S.a_ready(nxt);
            if constexpr (SP2) {
            PG8_LDB(B0, 0, 0); PG8_LDB(B1, 0, 1); PG8_SCHED; PG8_LDA(At, 0, 0); PG8_STAGE(PG8_SA(1, 1), a1 + hstepA, voffA);
            PG8_WAIT_V(8); PG8_WAIT_L(0); PG8_BAR; PG8_MMA(0, 0, At, B0); PG8_MMA(0, 1, At, B1); PG8_BAR; PG8_SCHED;
            PG8_LDA(At, 0, 1); PG8_STAGE(PG8_SB(0, 0), b2, voffB); PG8_STAGE(PG8_SB(0, 1), b2 + hstepB, voffB); PG8_STAGE(PG8_SA(0, 0), a2, voffA);
            PG8_WAIT_V(8); PG8_WAIT_L(0); PG8_BAR; PG8_MMA(1, 0, At, B0); PG8_MMA(1, 1, At, B1); PG8_BAR; PG8_SCHED;
            PG8_LDB(B0, 1, 0); PG8_LDB(B1, 1, 1); PG8_SCHED; PG8_LDA(At, 1, 0); PG8_STAGE(PG8_SA(0, 1), a2 + hstepA, voffA);
            PG8_WAIT_V(8); PG8_WAIT_L(0); PG8_BAR; PG8_MMA(0, 0, At, B0); PG8_MMA(0, 1, At, B1); PG8_BAR; PG8_SCHED;
            PG8_LDA(At, 1, 1); PG8_STAGE(PG8_SB(1, 0), b3, voffB); PG8_STAGE(PG8_SB(1, 1), b3 + hstepB, voffB); PG8_STAGE(PG8_SA(1, 0), a3, voffA);
            PG8_WAIT_V(8); PG8_WAIT_L(0); PG8_BAR; PG8_MMA(1, 0, At, B0); PG8_MMA(1, 1, At, B1); PG8_BAR; PG8_SCHED;
            } else {
            PG8_LDB(B0, 0, 0); PG8_SCHED; PG8_LDA(At, 0, 0); PG8_STAGE(PG8_SA(1, 1), a1 + hstepA, voffA);
            PG8_WAIT_L(8); PG8_BAR; PG8_WAIT_L(0); PG8_MMA(0, 0, At, B0); PG8_BAR; PG8_SCHED;
            PG8_LDB(B1, 0, 1); PG8_STAGE(PG8_SB(0, 0), b2, voffB);
            PG8_BAR; PG8_WAIT_L(0); PG8_MMA(0, 1, At, B1); PG8_BAR;
            PG8_LDA(At, 0, 1); PG8_STAGE(PG8_SA(0, 0), a2, voffA);
            PG8_BAR; PG8_WAIT_L(0); PG8_MMA(1, 0, At, B0); PG8_BAR; PG8_SCHED;
            PG8_STAGE(PG8_SB(0, 1), b2 + hstepB, voffB);
            PG8_WAIT_V(6); PG8_BAR; PG8_MMA(1, 1, At, B1); PG8_BAR;
            PG8_LDB(B0, 1, 0); PG8_SCHED; PG8_LDA(At, 1, 0); PG8_STAGE(PG8_SA(0, 1), a2 + hstepA, voffA);
            PG8_WAIT_L(8); PG8_BAR; PG8_WAIT_L(0); PG8_MMA(0, 0, At, B0); PG8_BAR; PG8_SCHED;
            PG8_LDB(B1, 1, 1); PG8_STAGE(PG8_SB(1, 0), b3, voffB);
            PG8_BAR; PG8_WAIT_L(0); PG8_MMA(0, 1, At, B1); PG8_BAR;
            PG8_LDA(At, 1, 1); PG8_STAGE(PG8_SA(1, 0), a3, voffA);
            PG8_BAR; PG8_WAIT_L(0); PG8_MMA(1, 0, At, B0); PG8_BAR; PG8_SCHED;
            PG8_STAGE(PG8_SB(1, 1), b3 + hstepB, voffB);
            PG8_WAIT_V(6); PG8_BAR; PG8_MMA(1, 1, At, B1); PG8_BAR;
            }
        }
        if constexpr (ALIGN_EPI) { if (wr == 0) PG8_BAR; }
        if constexpr (!Epi::AFTER_DRAIN) { E(acc, cur, wr, wc, fr, fq); S.done(cur); }
        if (!has_next) break;
#pragma unroll
        for (int a = 0; a < 2; ++a)
#pragma unroll
            for (int b = 0; b < 2; ++b)
#pragma unroll
                for (int m = 0; m < 4; ++m)
#pragma unroll
                    for (int n = 0; n < 2; ++n) acc[a][b][m][n] = (f32x4){0.f, 0.f, 0.f, 0.f};
        cur = nxt; cA = nA; cB = nB; ++ui;
        if constexpr (ALIGN_EPI) { if (wr == 1) PG8_BAR; }
    }
    PG8_WAIT_V(0);
    if constexpr (!ALIGN_EPI) { if (wr == 0) PG8_BAR; }
    PG8_BAR;
    if constexpr (Epi::AFTER_DRAIN) { E.fused(acc, cur, wr, wc, fr, fq, lds, wid, lane); S.done(cur); }
#undef PG8_SA
#undef PG8_SB
#undef PG8_STAGE
#undef PG8_LDA
#undef PG8_LDB
#undef PG8_MMA
#undef PG8_WAIT_V
#undef PG8_WAIT_L
#undef PG8_BAR
#undef PG8_SCHED
}
}

#define LAS __attribute__((address_space(3)))
typedef unsigned short bf16_t;
typedef float f32x4 __attribute__((ext_vector_type(4)));
typedef unsigned u32x4 __attribute__((ext_vector_type(4)));
typedef unsigned u32x2 __attribute__((ext_vector_type(2)));

constexpr int NWAVES = 8, NTHR = 512;
constexpr int D = 2048, BATCH = 4, SEQ = 2048, DEPTH = 4, DECB = 128;
constexpr int MP = BATCH * SEQ;
constexpr int MT = MP + DECB;
constexpr int MR = 8448;
constexpr int HH = 8, HK = 128, HV = 128, HW = 1024;
constexpr int GH = 4, GK = 128, GV = 256, GKW = 512, GVW = 1024, GR = 16;
constexpr int DFF = 8192, PLE = 256;
constexpr int NIN = 11280;
constexpr int NZ = 11776;
constexpr int C_GLR = 7168;
constexpr float EPS = 1e-6f;
constexpr int SSQW = 64;

constexpr size_t al256(size_t x) { return (x + 255) & ~(size_t)255; }
constexpr size_t WS_CTL = 0, CTL_BYTES = 1u << 20;
constexpr int CW_X6CNT = 8192, CW_X4CNT = 16384, CW_X6 = 32768, CW_X4 = 98304, CW_SSQ2 = 163840;
static_assert(CW_X6CNT + DEPTH * 32 * 64 <= CW_X4CNT && CW_X4CNT + DEPTH * 32 * 64 <= CW_X6 && CW_X6 + MP * 8 <= CW_X4 && CW_X4 + MP * 8 <= CW_SSQ2 && (size_t)(CW_SSQ2 + MR * 8) * 4 <= CTL_BYTES, "CTL sub-regions");
constexpr size_t WS_LBS = WS_CTL + CTL_BYTES;
constexpr size_t WS_SSQ = WS_LBS + al256(4 * 1024 * 4);
constexpr size_t WS_WIN = WS_SSQ + al256((size_t)MR * SSQW * 4);
constexpr size_t WS_WUH = WS_WIN + (size_t)DEPTH * NZ * D * 2;
constexpr size_t WS_WUG = WS_WUH + (size_t)DEPTH * D * HW * 2;
constexpr size_t WS_WOUT = WS_WUG + (size_t)DEPTH * D * GVW * 2;
constexpr size_t WS_WFF1 = WS_WOUT + (size_t)DEPTH * D * D * 2;
constexpr size_t WS_WFF2 = WS_WFF1 + (size_t)DEPTH * DFF * D * 2;
constexpr size_t WS_WPLE = WS_WFF2 + (size_t)DEPTH * D * DFF * 2;
constexpr size_t WS_WPLG = WS_WPLE + (size_t)DEPTH * D * PLE * 2;
constexpr size_t WS_H32 = WS_WPLG + (size_t)DEPTH * D * D * 2;
constexpr size_t WS_HBF3 = WS_H32;
constexpr size_t WS_HBF = WS_H32 + (size_t)MR * D * 4;
constexpr size_t WS_QH = WS_HBF + (size_t)MR * D * 2;
constexpr size_t WS_KH = WS_QH + (size_t)MR * HW * 2;
constexpr size_t WS_VH = WS_KH + (size_t)MR * HW * 2;
constexpr size_t WS_GHG = WS_VH + (size_t)MR * HW * 2;
constexpr size_t WS_LOGF = WS_GHG + (size_t)MR * HW * 2;
constexpr size_t WS_QG = WS_LOGF + (size_t)MR * HW * 4;
constexpr size_t WS_KG = WS_QG + (size_t)MR * GKW * 2;
constexpr size_t WS_VG = WS_KG + (size_t)MR * GKW * 2;
constexpr size_t WS_RG = WS_VG + (size_t)MR * GVW * 2;
constexpr size_t WS_LOGA = WS_RG + (size_t)MR * GVW * 2;
constexpr size_t WS_MH = WS_LOGA + (size_t)MR * GKW * 4;
constexpr size_t WS_MG = WS_MH + (size_t)MR * D * 2;
constexpr size_t WS_T32 = WS_MG + (size_t)MR * D * 2;
constexpr size_t WS_OG = WS_T32 + (size_t)MR * D * 4;
constexpr size_t WS_MRG = WS_OG + (size_t)MR * D * 2;
constexpr size_t WS_U = WS_MRG + (size_t)MR * D * 2;
constexpr size_t WS_PE = WS_U + (size_t)MR * DFF * 2;
constexpr size_t WS_HBF2 = WS_PE + (size_t)DEPTH * MR * D * 2;
constexpr size_t WS_PBF = WS_HBF2 + (size_t)MR * D * 2;
constexpr size_t WS_PART = WS_PBF + (size_t)DEPTH * MT * PLE * 2;
constexpr size_t WS_H32B = WS_PART + (size_t)12 * DECB * D * 4;
constexpr size_t WS_H32C = WS_H32B + (size_t)MR * D * 4;
constexpr size_t WS_END = WS_H32C + (size_t)MR * D * 4;

constexpr int LDS_BYTES = 147456;

struct P {
    const float *xp, *xs, *pp, *ps, *sth, *stg, *n_pre_mix, *n_post_mix, *n_pre_ffn, *n_post_ffn, *w_in, *lbp, *hgn, *w_hup, *wgg, *bgg, *gln, *w_gup, *w_out, *w_ff1, *w_ff2, *w_ple, *w_plg;
    float* out; unsigned char* ws;
};

__device__ __forceinline__ float bf2f(bf16_t b) { return __uint_as_float(((unsigned)b) << 16); }
__device__ __forceinline__ unsigned pk2(float lo, float hi) { return pg8::cvt_pk_bf16(lo, hi); }
__device__ __forceinline__ void unpack8(const u32x4 w, float (&v)[8]) {
    v[0] = __uint_as_float(w.x << 16); v[1] = __uint_as_float(w.x & 0xffff0000u); v[2] = __uint_as_float(w.y << 16); v[3] = __uint_as_float(w.y & 0xffff0000u);
    v[4] = __uint_as_float(w.z << 16); v[5] = __uint_as_float(w.z & 0xffff0000u); v[6] = __uint_as_float(w.w << 16); v[7] = __uint_as_float(w.w & 0xffff0000u);
}
__device__ __forceinline__ u32x4 pack8(const float (&v)[8]) { u32x4 w; w.x = pk2(v[0], v[1]); w.y = pk2(v[2], v[3]); w.z = pk2(v[4], v[5]); w.w = pk2(v[6], v[7]); return w; }
__device__ __forceinline__ float clampf(float x, float lo, float hi) { return __builtin_amdgcn_fmed3f(x, lo, hi); }
__device__ __forceinline__ float sigm(float x) { return __builtin_amdgcn_rcpf(1.f + __builtin_amdgcn_exp2f(x * -1.4426950408889634f)); }
__device__ __forceinline__ float silu(float x) { return x * sigm(x); }
__device__ __forceinline__ float wave_sum(float v) {
#pragma unroll
    for (int o = 1; o < 64; o <<= 1) v += __shfl_xor(v, o);
    return v;
}

struct FIn {
    const float* ssq; const float* lbs; const float* bgg; unsigned char* wsb;
    const LAS float* rst; int pm0, pm1, pm2;
    __device__ __forceinline__ float rowctx(int row) const {
        const int pm = row >> 8, rl = row & 255;
        if (pm == pm0) return rst[rl];
        if (pm == pm1) return rst[256 + rl];
        if (pm == pm2) return rst[512 + rl];
        float sc = 0.f; const int np = row >= MP ? SSQW : 8;
#pragma nounroll
        for (int i = 0; i < np; ++i) sc += ssq[(size_t)row * SSQW + i];
        return rsqrtf(sc * (1.f / D) + EPS);
    }
    __device__ __forceinline__ float rowctx_g(int row) const {
        const f32x4* p = (const f32x4*)(ssq + (size_t)row * SSQW); float s = 0.f;
        { const f32x4 x = p[0], y = p[1]; s = ((x[0] + x[1]) + (x[2] + x[3])) + ((y[0] + y[1]) + (y[2] + y[3])); }
        if (row >= MP) {
#pragma unroll
            for (int i = 2; i < SSQW / 4; ++i) { const f32x4 x = p[i]; s += (x[0] + x[1]) + (x[2] + x[3]); } }
        return rsqrtf(s * (1.f / D) + EPS);
    }
    __device__ __forceinline__ void apply8(int row, int col, const float (&a)[8], float rs) const {
        float v[8];
#pragma unroll
        for (int j = 0; j < 8; ++j) v[j] = a[j] * rs;
        const float rsn = rs * -1.4426950408889634f;
        if (col < 1024) {
#pragma unroll
            for (int j = 0; j < 8; ++j) v[j] = v[j] * __builtin_amdgcn_rcpf(1.f + __builtin_amdgcn_exp2f(a[j] * rsn));
            *(u32x4*)((bf16_t*)(wsb + WS_QH) + (size_t)row * HW + col) = pack8(v);
        } else if (col < 2048) {
            const int c = col - 1024; float lg[8], kk[8];
            const f32x4 l0 = *(const f32x4*)(lbs + c), l1 = *(const f32x4*)(lbs + c + 4);
#pragma unroll
            for (int j = 0; j < 8; ++j) { const float lb = j < 4 ? l0[j] : l1[j - 4]; const float e = __expf(-clampf(v[j], -30.f, 30.f)); const float sg = __builtin_amdgcn_rcpf(1.f + e);
                lg[j] = __builtin_amdgcn_logf(lb + (1.f - lb) * sg) * 0.6931471805599453f; kk[j] = (1.f - lb) * e * sg; }
            *(f32x4*)((float*)(wsb + WS_LOGF) + (size_t)row * HW + c) = (f32x4){lg[0], lg[1], lg[2], lg[3]}; *(f32x4*)((float*)(wsb + WS_LOGF) + (size_t)row * HW + c + 4) = (f32x4){lg[4], lg[5], lg[6], lg[7]};
            *(u32x4*)((bf16_t*)(wsb + WS_KH) + (size_t)row * HW + c) = pack8(kk);
        } else if (col < 3072) {
            *(u32x4*)((bf16_t*)(wsb + WS_VH) + (size_t)row * HW + (col - 2048)) = pack8(v);
        } else if (col < 4096) {
#pragma unroll
            for (int j = 0; j < 8; ++j) v[j] = v[j] * __builtin_amdgcn_rcpf(1.f + __builtin_amdgcn_exp2f(a[j] * rsn));
            *(u32x4*)((bf16_t*)(wsb + WS_GHG) + (size_t)row * HW + (col - 3072)) = pack8(v);
        } else if (col < 4608) {
            *(u32x4*)((bf16_t*)(wsb + WS_QG) + (size_t)row * GKW + (col - 4096)) = pack8(v);
        } else if (col < 5120) {
            *(u32x4*)((bf16_t*)(wsb + WS_KG) + (size_t)row * GKW + (col - 4608)) = pack8(v);
        } else if (col < 6144) {
            *(u32x4*)((bf16_t*)(wsb + WS_VG) + (size_t)row * GVW + (col - 5120)) = pack8(v);
        } else if (col < 7168) {
#pragma unroll
            for (int j = 0; j < 8; ++j) v[j] = v[j] * __builtin_amdgcn_rcpf(1.f + __builtin_amdgcn_exp2f(a[j] * rsn));
            *(u32x4*)((bf16_t*)(wsb + WS_RG) + (size_t)row * GVW + (col - 6144)) = pack8(v);
        } else if (col < 7680) {
            const int c = col - 7168; float lg[8];
            const f32x4 b0 = *(const f32x4*)(bgg + c), b1 = *(const f32x4*)(bgg + c + 4);
#pragma unroll
            for (int j = 0; j < 8; ++j) { const float x = v[j] + (j < 4 ? b0[j] : b1[j - 4]); lg[j] = (fminf(x, 0.f) - __builtin_amdgcn_logf(1.f + __expf(-fabsf(x))) * 0.6931471805599453f) * (1.f / 16.f); }
            *(f32x4*)((float*)(wsb + WS_LOGA) + (size_t)row * GKW + c) = (f32x4){lg[0], lg[1], lg[2], lg[3]}; *(f32x4*)((float*)(wsb + WS_LOGA) + (size_t)row * GKW + c + 4) = (f32x4){lg[4], lg[5], lg[6], lg[7]};
        } else if (col < 9728) {
#pragma unroll
            for (int j = 0; j < 8; ++j) v[j] = __builtin_amdgcn_rcpf(1.f + __builtin_amdgcn_exp2f(a[j] * rsn));
            *(u32x4*)((bf16_t*)(wsb + WS_MH) + (size_t)row * D + (col - 7680)) = pack8(v);
        } else {
#pragma unroll
            for (int j = 0; j < 8; ++j) v[j] = __builtin_amdgcn_rcpf(1.f + __builtin_amdgcn_exp2f(a[j] * rsn));
            *(u32x4*)((bf16_t*)(wsb + WS_MG) + (size_t)row * D + (col - 9728)) = pack8(v);
        }
    }
};
#ifndef PD1
#define PD1 8
#endif
#ifndef PD2
#define PD2 4
#endif
#ifndef PD3
#define PD3 4
#endif
#ifndef PD6
#define PD6 4
#endif
struct FUp1 {
    const bf16_t* mh; bf16_t* T;
    __device__ __forceinline__ float rowctx(int) const { return 0.f; }
    __device__ __forceinline__ void apply8(int row, int col, const float (&a)[8], float) const {
        float g[8], v[8]; unpack8(*(const u32x4*)(mh + (size_t)row * D + col), g);
#pragma unroll
        for (int j = 0; j < 8; ++j) v[j] = a[j] * g[j];
        *(u32x4*)(T + (size_t)row * D + col) = pack8(v);
    }
    struct Pre { u32x4 g; }; static constexpr int PDIST = PD1;
    __device__ __forceinline__ Pre preload(int row, int col) const { return Pre{*(const u32x4*)(mh + (size_t)row * D + col)}; }
    __device__ __forceinline__ void apply8p(int row, int col, const float (&a)[8], const Pre& p) const {
        float g[8], v[8]; unpack8(p.g, g);
#pragma unroll
        for (int j = 0; j < 8; ++j) v[j] = a[j] * g[j];
        *(u32x4*)(T + (size_t)row * D + col) = pack8(v);
    }
};
struct FUp2 {
    const bf16_t* mg; const bf16_t* T; bf16_t* out;
    __device__ __forceinline__ float rowctx(int) const { return 0.f; }
    __device__ __forceinline__ void apply8(int row, int col, const float (&a)[8], float) const {
        float g[8], v[8]; unpack8(*(const u32x4*)(mg + (size_t)row * D + col), g);
        float t[8]; unpack8(*(const u32x4*)(T + (size_t)row * D + col), t);
#pragma unroll
        for (int j = 0; j < 8; ++j) v[j] = t[j] + a[j] * g[j];
        *(u32x4*)(out + (size_t)row * D + col) = pack8(v);
    }
    struct Pre { u32x4 g, t; }; static constexpr int PDIST = PD2;
    __device__ __forceinline__ Pre preload(int row, int col) const { return Pre{*(const u32x4*)(mg + (size_t)row * D + col), *(const u32x4*)(T + (size_t)row * D + col)}; }
    __device__ __forceinline__ void apply8p(int row, int col, const float (&a)[8], const Pre& p) const {
        float g[8], t[8], v[8]; unpack8(p.g, g); unpack8(p.t, t);
#pragma unroll
        for (int j = 0; j < 8; ++j) v[j] = t[j] + a[j] * g[j];
        *(u32x4*)(out + (size_t)row * D + col) = pack8(v);
    }
};
struct FPartS {
    float* dst;
    __device__ __forceinline__ float rowctx(int) const { return 0.f; }
    __device__ __forceinline__ void apply8(int row, int col, const float (&a)[8], float) const {
        float* q = dst + (size_t)(row - MP) * D + col; *(f32x4*)q = (f32x4){a[0], a[1], a[2], a[3]}; *(f32x4*)(q + 4) = (f32x4){a[4], a[5], a[6], a[7]}; }
};
struct FStoreBf {
    bf16_t* T;
    __device__ __forceinline__ float rowctx(int) const { return 0.f; }
    __device__ __forceinline__ void apply8(int row, int col, const float (&a)[8], float) const { float v[8];
#pragma unroll
        for (int j = 0; j < 8; ++j) v[j] = a[j];
        *(u32x4*)(T + (size_t)row * D + col) = pack8(v); }
};
struct FStore32 {
    float* T; int ld;
    __device__ __forceinline__ float rowctx(int) const { return 0.f; }
    __device__ __forceinline__ void apply8(int row, int col, const float (&a)[8], float) const {
        *(f32x4*)(T + (size_t)row * ld + col) = (f32x4){a[0], a[1], a[2], a[3]}; *(f32x4*)(T + (size_t)row * ld + col + 4) = (f32x4){a[4], a[5], a[6], a[7]};
    }
};
struct FRelu2 {
    bf16_t* U; const float* ssq2; const LAS float* rst; int pm0, pm1, pm2, pm3;
    __device__ __forceinline__ float rowctx_g(int row) const {
        const f32x4* p = (const f32x4*)(ssq2 + (size_t)row * 8); const f32x4 x = p[0], y = p[1];
        return rsqrtf((((x[0] + x[1]) + (x[2] + x[3])) + ((y[0] + y[1]) + (y[2] + y[3]))) * (1.f / D) + EPS); }
    __device__ __forceinline__ float rowctx(int row) const {
        const int pm = row >> 8, rl = row & 255;
        if (pm == pm0) return rst[rl];
        if (pm == pm1) return rst[256 + rl];
        if (pm == pm2) return rst[512 + rl];
        if (pm == pm3) return rst[768 + rl];
        return rowctx_g(row); }
    __device__ __forceinline__ void apply8(int row, int col, const float (&a)[8], float rs) const {
        float v[8];
#pragma unroll
        for (int j = 0; j < 8; ++j) { const float r = fmaxf(a[j], 0.f) * rs; v[j] = r * r; }
        *(u32x4*)(U + (size_t)row * DFF + col) = pack8(v);
    }
};
struct FPe {
    bf16_t* O;
    __device__ __forceinline__ float rowctx(int) const { return 0.f; }
    __device__ __forceinline__ void apply8(int row, int col, const float (&a)[8], float) const { float v[8];
#pragma unroll
        for (int j = 0; j < 8; ++j) v[j] = a[j];
        *(u32x4*)(O + (size_t)row * D + col) = pack8(v); }
};
struct FPeD {
    bf16_t* pe;
    __device__ __forceinline__ float rowctx(int) const { return 0.f; }
    __device__ __forceinline__ void apply8(int row, int col, const float (&a)[8], float) const { float v[8]; const int ll = col >> 11;
#pragma unroll
        for (int j = 0; j < 8; ++j) v[j] = a[j];
        *(u32x4*)(pe + ((size_t)ll * MR + (row - ll * MP)) * D + (col & (D - 1))) = pack8(v); }
};
struct DiagOrder {
    int G, c;
    __device__ __forceinline__ bool next(int i, pg8::Unit& u) const { const int L = i * G + c; if (L >= DEPTH * 256) return false; const int ll = L >> 8, r = L & 255; u.pm = ll * 32 + (r >> 3); u.pn = ll * 8 + (r & 7); return true; }
    __device__ __forceinline__ void a_ready(const pg8::Unit&) const {}
    __device__ __forceinline__ void done(const pg8::Unit&) const {}
};
struct FPle {
    const bf16_t* h2; float* out32; bf16_t* hbf; const bf16_t* pe;
    __device__ __forceinline__ float apply8s(int row, int col, const float (&a)[8]) const {
        float e[8], v[8]; unpack8(*(const u32x4*)(pe + (size_t)row * D + col), e);
        float hh[8]; unpack8(*(const u32x4*)(h2 + (size_t)row * D + col), hh); float s = 0.f;
#pragma unroll
        for (int j = 0; j < 8; ++j) { v[j] = hh[j] + sigm(a[j]) * e[j]; s += v[j] * v[j]; }
        if (out32) { *(f32x4*)(out32 + (size_t)row * D + col) = (f32x4){v[0], v[1], v[2], v[3]}; *(f32x4*)(out32 + (size_t)row * D + col + 4) = (f32x4){v[4], v[5], v[6], v[7]}; }
        *(u32x4*)(hbf + (size_t)row * D + col) = pack8(v);
        return s;
    }
    struct Pre { u32x4 e, hh; }; static constexpr int PDIST = PD3;
    __device__ __forceinline__ Pre preload(int row, int col) const { return Pre{*(const u32x4*)(pe + (size_t)row * D + col), *(const u32x4*)(h2 + (size_t)row * D + col)}; }
    __device__ __forceinline__ float apply8sp(int row, int col, const float (&a)[8], const Pre& p) const {
        float e[8], hh[8], v[8]; unpack8(p.e, e); unpack8(p.hh, hh); float s = 0.f;
#pragma unroll
        for (int j = 0; j < 8; ++j) { v[j] = hh[j] + sigm(a[j]) * e[j]; s += v[j] * v[j]; }
        if (out32) { *(f32x4*)(out32 + (size_t)row * D + col) = (f32x4){v[0], v[1], v[2], v[3]}; *(f32x4*)(out32 + (size_t)row * D + col + 4) = (f32x4){v[4], v[5], v[6], v[7]}; }
        *(u32x4*)(hbf + (size_t)row * D + col) = pack8(v);
        return s;
    }
};

template <class F> struct EpiA {
    static constexpr bool PERM = true, AFTER_DRAIN = false; F f;
    __device__ __forceinline__ void operator()(const f32x4 (&acc)[2][2][4][2], const pg8::Unit& u, int wr, int wc, int fr, int fq) const {
#pragma unroll
        for (int ai = 0; ai < 2; ++ai)
#pragma unroll
            for (int m = 0; m < 4; ++m) { const int row = u.pm * 256 + ai * 128 + wr * 64 + m * 16 + fr; const float ctx = f.rowctx(row);
#pragma unroll
                for (int bj = 0; bj < 2; ++bj) { const int col = u.pn * 256 + bj * 128 + wc * 32 + 8 * fq;
                    const float v[8] = {acc[ai][bj][m][0][0], acc[ai][bj][m][0][1], acc[ai][bj][m][0][2], acc[ai][bj][m][0][3], acc[ai][bj][m][1][0], acc[ai][bj][m][1][1], acc[ai][bj][m][1][2], acc[ai][bj][m][1][3]};
                    f.apply8(row, col, v, ctx); } }
    }
};
template <class F> struct EpiAP {
    static constexpr bool PERM = true, AFTER_DRAIN = false; F f;
    __device__ __forceinline__ void operator()(const f32x4 (&acc)[2][2][4][2], const pg8::Unit& u, int wr, int wc, int fr, int fq) const {
        typename F::Pre pre[16];
        const int row0 = u.pm * 256 + wr * 64 + fr, col0 = u.pn * 256 + wc * 32 + 8 * fq;
#define EPG_ROW(g) (row0 + ((g) >> 3) * 128 + (((g) >> 1) & 3) * 16)
#define EPG_COL(g) (col0 + ((g) & 1) * 128)
#pragma unroll
        for (int g = 0; g < F::PDIST; ++g) pre[g] = f.preload(EPG_ROW(g), EPG_COL(g));
#pragma unroll
        for (int g = 0; g < 16; ++g) { const int ai = g >> 3, m = (g >> 1) & 3, bj = g & 1;
            if (g + F::PDIST < 16) { pre[(g + F::PDIST) & 15] = f.preload(EPG_ROW(g + F::PDIST), EPG_COL(g + F::PDIST)); }
            const float v[8] = {acc[ai][bj][m][0][0], acc[ai][bj][m][0][1], acc[ai][bj][m][0][2], acc[ai][bj][m][0][3], acc[ai][bj][m][1][0], acc[ai][bj][m][1][1], acc[ai][bj][m][1][2], acc[ai][bj][m][1][3]};
            f.apply8p(EPG_ROW(g), EPG_COL(g), v, pre[g]);
            }
    }
};
struct EpiPle {
    static constexpr bool PERM = true, AFTER_DRAIN = true; FPle f; float* ssq;
    __device__ __forceinline__ void operator()(const f32x4 (&)[2][2][4][2], const pg8::Unit&, int, int, int, int) const {}
    __device__ __forceinline__ void fused(f32x4 (&acc)[2][2][4][2], const pg8::Unit& u, int wr, int wc, int fr, int fq, LAS unsigned char* lds, int wid, int lane) const {
        LAS float* Pq = (LAS float*)lds;
        FPle::Pre pre[16];
        const int row0 = u.pm * 256 + wr * 64 + fr, col0 = u.pn * 256 + wc * 32 + 8 * fq;
#pragma unroll
        for (int g = 0; g < FPle::PDIST; ++g) pre[g] = f.preload(EPG_ROW(g), EPG_COL(g));
        float s = 0.f;
#pragma unroll
        for (int g = 0; g < 16; ++g) { const int ai = g >> 3, m = (g >> 1) & 3, bj = g & 1;
            if (g + FPle::PDIST < 16) { pre[(g + FPle::PDIST) & 15] = f.preload(EPG_ROW(g + FPle::PDIST), EPG_COL(g + FPle::PDIST)); }
            const float v[8] = {acc[ai][bj][m][0][0], acc[ai][bj][m][0][1], acc[ai][bj][m][0][2], acc[ai][bj][m][0][3], acc[ai][bj][m][1][0], acc[ai][bj][m][1][1], acc[ai][bj][m][1][2], acc[ai][bj][m][1][3]};
            s += f.apply8sp(EPG_ROW(g), EPG_COL(g), v, pre[g]);
            if (bj == 1) { s += __shfl_xor(s, 16); s += __shfl_xor(s, 32);
                if (fq == 0) Pq[(ai * 128 + wr * 64 + m * 16 + fr) * 4 + wc] = s;
                s = 0.f; }
            }
        asm volatile("s_waitcnt lgkmcnt(0)" ::: "memory"); __builtin_amdgcn_s_barrier(); asm volatile("" ::: "memory");
        const int t = wid * 64 + lane;
        if (t < 256) { const f32x4 q = *(const LAS f32x4*)(Pq + t * 4); ssq[(size_t)(u.pm * 256 + t) * SSQW + u.pn] = (q[0] + q[1]) + (q[2] + q[3]); }
        asm volatile("s_waitcnt lgkmcnt(0)" ::: "memory"); __builtin_amdgcn_s_barrier(); asm volatile("" ::: "memory");
    }
};

__device__ __forceinline__ void ld_sc1_2x4(const float* p, f32x4& a, f32x4& b) {
    asm volatile("global_load_dwordx4 %0, %2, off sc1\n\tglobal_load_dwordx4 %1, %2, off offset:16 sc1\n\ts_waitcnt vmcnt(0)" : "=&v"(a), "=&v"(b) : "v"(p) : "memory"); }
__device__ __forceinline__ void ld_sc1_4x4(const float* p0, const float* p1, const float* p2, const float* p3, f32x4& a, f32x4& b, f32x4& c, f32x4& d) {
    asm volatile("global_load_dwordx4 %0, %4, off sc1\n\tglobal_load_dwordx4 %1, %5, off sc1\n\tglobal_load_dwordx4 %2, %6, off sc1\n\tglobal_load_dwordx4 %3, %7, off sc1\n\ts_waitcnt vmcnt(0)"
                 : "=&v"(a), "=&v"(b), "=&v"(c), "=&v"(d) : "v"(p0), "v"(p1), "v"(p2), "v"(p3) : "memory"); }
__device__ __forceinline__ void panel_rstd(const f32x4 (&acc)[2][2][4][2], const pg8::Unit& u, int wr, int wc, int fr, int fq, LAS float* Pq, LAS float* S, float* xbuf, unsigned* cnt, unsigned* tmo, int wid, int lane) {
#pragma unroll
    for (int ai = 0; ai < 2; ++ai)
#pragma unroll
        for (int m = 0; m < 4; ++m) { float s = 0.f;
#pragma unroll
            for (int bj = 0; bj < 2; ++bj)
#pragma unroll
                for (int n = 0; n < 2; ++n) { const f32x4 x = acc[ai][bj][m][n]; s += (x[0] * x[0] + x[1] * x[1]) + (x[2] * x[2] + x[3] * x[3]); }
            s += __shfl_xor(s, 16); s += __shfl_xor(s, 32);
            if (fq == 0) Pq[(ai * 128 + wr * 64 + m * 16 + fr) * 4 + wc] = s; }
    const int t = wid * 64 + lane;
    asm volatile("s_waitcnt lgkmcnt(0)" ::: "memory"); __builtin_amdgcn_s_barrier(); asm volatile("" ::: "memory");
    if (t < 256) { const f32x4 q = *(const LAS f32x4*)(Pq + t * 4);
        __hip_atomic_store(xbuf + (size_t)(u.pm * 256 + t) * 8 + u.pn, (q[0] + q[1]) + (q[2] + q[3]), __ATOMIC_RELAXED, __HIP_MEMORY_SCOPE_AGENT); }
    asm volatile("s_waitcnt vmcnt(0)" ::: "memory");
    if (wid < 4 && lane == 0) __hip_atomic_fetch_add(cnt + 64 * u.pm, 1u, __ATOMIC_RELAXED, __HIP_MEMORY_SCOPE_AGENT);
    if (wid == 0) { unsigned sp = 0u;
        while ((unsigned)__builtin_amdgcn_readfirstlane(__hip_atomic_load(cnt + 64 * u.pm, __ATOMIC_RELAXED, __HIP_MEMORY_SCOPE_AGENT)) < 32u) {
            __builtin_amdgcn_s_sleep(1);
            if ((++sp & 255u) == 0u) { if (__hip_atomic_load(tmo, __ATOMIC_RELAXED, __HIP_MEMORY_SCOPE_AGENT)) break; if (sp > (1u << 18)) { if (lane == 0) atomicAdd(tmo, 1u); break; } } }
        __builtin_amdgcn_fence(__ATOMIC_ACQUIRE, "agent"); }
    asm volatile("s_waitcnt vmcnt(0) lgkmcnt(0)" ::: "memory"); __builtin_amdgcn_s_barrier(); asm volatile("" ::: "memory");
    if (t < 256) { const float* slot = xbuf + (size_t)(u.pm * 256 + t) * 8; f32x4 a, b; ld_sc1_2x4(slot, a, b);
        const float s = ((a[0] + a[1]) + (a[2] + a[3])) + ((b[0] + b[1]) + (b[2] + b[3]));
        S[t] = rsqrtf(s * (1.f / D) + EPS); }
    asm volatile("s_waitcnt vmcnt(0) lgkmcnt(0)" ::: "memory"); __builtin_amdgcn_s_barrier(); asm volatile("" ::: "memory");
}
struct EpiPost6 {
    static constexpr bool PERM = true, AFTER_DRAIN = true;
    const bf16_t* h1; const float* g3; bf16_t* hdst; float* xbuf; unsigned* cnt; unsigned* tmo;
    struct Pre { u32x4 hh; };
    __device__ __forceinline__ Pre preload(int row, int col) const { return Pre{*(const u32x4*)(h1 + (size_t)row * D + col)}; }
    __device__ __forceinline__ void operator()(const f32x4 (&)[2][2][4][2], const pg8::Unit&, int, int, int, int) const {}
    __device__ __forceinline__ void fused(f32x4 (&acc)[2][2][4][2], const pg8::Unit& u, int wr, int wc, int fr, int fq, LAS unsigned char* lds, int wid, int lane) const {
        LAS float* Pq = (LAS float*)lds;
        LAS float* S3 = (LAS float*)(lds + 4096);
        LAS float* G3 = (LAS float*)(lds + 7168);
        const int row0 = u.pm * 256 + wr * 64 + fr, col0 = u.pn * 256 + wc * 32 + 8 * fq;
        Pre pre[16];
#pragma unroll
        for (int g = 0; g < PD6; ++g) pre[g] = preload(EPG_ROW(g), EPG_COL(g));
        const int t = wid * 64 + lane;
        if (t >= 256) G3[t - 256] = g3[u.pn * 256 + t - 256];
        panel_rstd(acc, u, wr, wc, fr, fq, Pq, S3, xbuf, cnt, tmo, wid, lane);
#pragma unroll
        for (int g = 0; g < 16; ++g) { const int ai = g >> 3, m = (g >> 1) & 3, bj = g & 1;
            if (g + PD6 < 16) { pre[(g + PD6) & 15] = preload(EPG_ROW(g + PD6), EPG_COL(g + PD6)); }
            const int rl = ai * 128 + wr * 64 + m * 16 + fr, cl = bj * 128 + wc * 32 + 8 * fq;
            const float r3 = S3[rl];
            const f32x4 fa = *(const LAS f32x4*)(G3 + cl) * r3, fb = *(const LAS f32x4*)(G3 + cl + 4) * r3;
            float hh[8], v[8]; unpack8(pre[g].hh, hh);
#pragma unroll
            for (int j = 0; j < 4; ++j) { v[j] = hh[j] + acc[ai][bj][m][0][j] * fa[j]; v[4 + j] = hh[4 + j] + acc[ai][bj][m][1][j] * fb[j]; }
            *(u32x4*)(hdst + (size_t)EPG_ROW(g) * D + EPG_COL(g)) = pack8(v);
            }
    }
};
struct EpiPost4 {
    static constexpr bool PERM = true, AFTER_DRAIN = true;
    const bf16_t* h; const float* g1; bf16_t* h1dst; float* ssq2; float* xbuf; unsigned* cnt; unsigned* tmo;
    struct Pre { u32x4 hh; };
    __device__ __forceinline__ Pre preload(int row, int col) const { return Pre{*(const u32x4*)(h + (size_t)row * D + col)}; }
    __device__ __forceinline__ void operator()(const f32x4 (&)[2][2][4][2], const pg8::Unit&, int, int, int, int) const {}
    __device__ __forceinline__ void fused(f32x4 (&acc)[2][2][4][2], const pg8::Unit& u, int wr, int wc, int fr, int fq, LAS unsigned char* lds, int wid, int lane) const {
        LAS float* Pq = (LAS float*)lds;
        LAS float* S1 = (LAS float*)(lds + 4096);
        LAS float* G1 = (LAS float*)(lds + 7168);
        const int row0 = u.pm * 256 + wr * 64 + fr, col0 = u.pn * 256 + wc * 32 + 8 * fq;
        Pre pre[16];
#pragma unroll
        for (int g = 0; g < PD6; ++g) pre[g] = preload(EPG_ROW(g), EPG_COL(g));
        const int t = wid * 64 + lane;
        if (t >= 256) G1[t - 256] = g1[u.pn * 256 + t - 256];
        panel_rstd(acc, u, wr, wc, fr, fq, Pq, S1, xbuf, cnt, tmo, wid, lane);
        float s2 = 0.f;
#pragma unroll
        for (int g = 0; g < 16; ++g) { const int ai = g >> 3, m = (g >> 1) & 3, bj = g & 1;
            if (g + PD6 < 16) { pre[(g + PD6) & 15] = preload(EPG_ROW(g + PD6), EPG_COL(g + PD6)); }
            const int rl = ai * 128 + wr * 64 + m * 16 + fr, cl = bj * 128 + wc * 32 + 8 * fq;
            const float r1 = S1[rl];
            const f32x4 ga = *(const LAS f32x4*)(G1 + cl) * r1, gb = *(const LAS f32x4*)(G1 + cl + 4) * r1;
            float hh[8], v[8]; unpack8(pre[g].hh, hh);
#pragma unroll
            for (int j = 0; j < 4; ++j) { v[j] = hh[j] + acc[ai][bj][m][0][j] * ga[j]; v[4 + j] = hh[4 + j] + acc[ai][bj][m][1][j] * gb[j]; }
#pragma unroll
            for (int j = 0; j < 8; ++j) s2 += v[j] * v[j];
            *(u32x4*)(h1dst + (size_t)EPG_ROW(g) * D + EPG_COL(g)) = pack8(v);
            if (bj == 1) { s2 += __shfl_xor(s2, 16); s2 += __shfl_xor(s2, 32);
                if (fq == 0) Pq[rl * 4 + wc] = s2;
                s2 = 0.f; }
            }
        asm volatile("s_waitcnt lgkmcnt(0)" ::: "memory"); __builtin_amdgcn_s_barrier(); asm volatile("" ::: "memory");
        if (t < 256) { const f32x4 q = *(const LAS f32x4*)(Pq + t * 4); ssq2[(size_t)(u.pm * 256 + t) * 8 + u.pn] = (q[0] + q[1]) + (q[2] + q[3]); }
        asm volatile("s_waitcnt lgkmcnt(0)" ::: "memory"); __builtin_amdgcn_s_barrier(); asm volatile("" ::: "memory");
    }
};

__device__ __forceinline__ void transpose_item(const float* W, int ldw, const float* kgain, float scale, bf16_t* WT, int ldt, int k0, int n_src0, int n_dst0, LAS float* scr, int lane) {
    float wv[32];
#pragma unroll
    for (int i = 0; i < 32; ++i) wv[i] = W[(size_t)(k0 + 2 * i + (lane >> 5)) * ldw + n_src0 + (lane & 31)];
    if (kgain) {
#pragma unroll
        for (int i = 0; i < 32; ++i) wv[i] *= kgain[k0 + 2 * i + (lane >> 5)] * scale; }
#pragma unroll
    for (int i = 0; i < 32; ++i) scr[(2 * i + (lane >> 5)) * 33 + (lane & 31)] = wv[i];
    asm volatile("s_waitcnt lgkmcnt(0)" ::: "memory");
    const int c = lane & 7;
#pragma unroll
    for (int j = 0; j < 4; ++j) { const int n = (lane >> 3) + 8 * j; const LAS float* s = scr + (8 * c) * 33 + n;
        u32x4 o; o.x = pk2(s[0 * 33], s[1 * 33]); o.y = pk2(s[2 * 33], s[3 * 33]); o.z = pk2(s[4 * 33], s[5 * 33]); o.w = pk2(s[6 * 33], s[7 * 33]);
        *(u32x4*)(WT + (size_t)(n_dst0 + n) * ldt + k0 + 8 * c) = o; }
    asm volatile("s_waitcnt lgkmcnt(0)" ::: "memory");
}
__device__ __forceinline__ void fold_item(const float* Win, const float* wgg, const float* kgain, bf16_t* WT, int k0, int j0, int n_dst0, LAS float* scr, int lane) {
    float wg[GR];
#pragma unroll
    for (int r = 0; r < GR; ++r) wg[r] = wgg[r * GKW + j0 + (lane & 31)];
#pragma unroll 8
    for (int i = 0; i < 32; ++i) { const int kk = 2 * i + (lane >> 5); const f32x4* wr = (const f32x4*)(Win + (size_t)(k0 + kk) * NIN + C_GLR); float s = 0.f;
#pragma unroll
        for (int r4 = 0; r4 < GR / 4; ++r4) { const f32x4 x = wr[r4]; s += (x[0] * wg[4 * r4] + x[1] * wg[4 * r4 + 1]) + (x[2] * wg[4 * r4 + 2] + x[3] * wg[4 * r4 + 3]); }
        scr[kk * 33 + (lane & 31)] = s * kgain[k0 + kk]; }
    asm volatile("s_waitcnt lgkmcnt(0)" ::: "memory");
    const int c = lane & 7;
#pragma unroll
    for (int j = 0; j < 4; ++j) { const int n = (lane >> 3) + 8 * j; const LAS float* s = scr + (8 * c) * 33 + n;
        u32x4 o; o.x = pk2(s[0 * 33], s[1 * 33]); o.y = pk2(s[2 * 33], s[3 * 33]); o.z = pk2(s[4 * 33], s[5 * 33]); o.w = pk2(s[6 * 33], s[7 * 33]);
        *(u32x4*)(WT + (size_t)(n_dst0 + n) * D + k0 + 8 * c) = o; }
    asm volatile("s_waitcnt lgkmcnt(0)" ::: "memory");
}

__device__ __forceinline__ void phase_prologue(const P& p, unsigned char* ws, LAS unsigned char* lds, int wg, int nwg) {
    const int tid = tidx(), lane = tid & 63, wave = tid >> 6;
    LAS float* scr = (LAS float*)(lds + wave * 16384);
    const int gw = wg * NWAVES + wave, NGW = nwg * NWAVES;
    constexpr int I_IN = (D / 64) * (NZ / 32), I_UH = (HW / 64) * (D / 32), I_UG = I_UH, I_OUT = (D / 64) * (D / 32), I_F1 = (D / 64) * (DFF / 32), I_F2 = (DFF / 64) * (D / 32), I_PL = (PLE / 64) * (D / 32), I_PG = I_OUT;
    constexpr int I_LAYER = I_IN + I_UH + I_UG + I_OUT + I_F1 + I_F2 + I_PL + I_PG;
    for (int it = gw; it < DEPTH * I_LAYER; it += NGW) {
        const int l = it / I_LAYER; int r = it % I_LAYER;
        if (r < I_IN) { const int nb = r % (NZ / 32), kb = r / (NZ / 32), n0 = nb * 32; bf16_t* WT = (bf16_t*)(ws + WS_WIN) + (size_t)l * NZ * D; const float* Win = p.w_in + (size_t)l * D * NIN; const float* kg = p.n_pre_mix + l * D;
            if (n0 >= 7168 && n0 < 7680) fold_item(Win, p.wgg + (size_t)l * GR * GKW, kg, WT, kb * 64, n0 - 7168, n0, scr, lane);
            else { const int ns = n0 < 7168 ? n0 : n0 - 496; const float sc = (n0 >= 4096 && n0 < 4608) ? 0.08838834764831845f : 1.f; transpose_item(Win, NIN, kg, sc, WT, D, kb * 64, ns, n0, scr, lane); }
            continue; } r -= I_IN;
        if (r < I_UH) { transpose_item(p.w_hup + (size_t)l * HW * D, D, nullptr, 1.f, (bf16_t*)(ws + WS_WUH) + (size_t)l * D * HW, HW, (r / (D / 32)) * 64, (r % (D / 32)) * 32, (r % (D / 32)) * 32, scr, lane); continue; } r -= I_UH;
        if (r < I_UG) { transpose_item(p.w_gup + (size_t)l * GVW * D, D, nullptr, 1.f, (bf16_t*)(ws + WS_WUG) + (size_t)l * D * GVW, GVW, (r / (D / 32)) * 64, (r % (D / 32)) * 32, (r % (D / 32)) * 32, scr, lane); continue; } r -= I_UG;
        if (r < I_OUT) { transpose_item(p.w_out + (size_t)l * D * D, D, nullptr, 1.f, (bf16_t*)(ws + WS_WOUT) + (size_t)l * D * D, D, (r / (D / 32)) * 64, (r % (D / 32)) * 32, (r % (D / 32)) * 32, scr, lane); continue; } r -= I_OUT;
        if (r < I_F1) { transpose_item(p.w_ff1 + (size_t)l * D * DFF, DFF, p.n_pre_ffn + l * D, 1.f, (bf16_t*)(ws + WS_WFF1) + (size_t)l * DFF * D, D, (r / (DFF / 32)) * 64, (r % (DFF / 32)) * 32, (r % (DFF / 32)) * 32, scr, lane); continue; } r -= I_F1;
        if (r < I_F2) { transpose_item(p.w_ff2 + (size_t)l * DFF * D, D, nullptr, 1.f, (bf16_t*)(ws + WS_WFF2) + (size_t)l * D * DFF, DFF, (r / (D / 32)) * 64, (r % (D / 32)) * 32, (r % (D / 32)) * 32, scr, lane); continue; } r -= I_F2;
        if (r < I_PL) { transpose_item(p.w_ple + (size_t)l * PLE * D, D, nullptr, 1.f, (bf16_t*)(ws + WS_WPLE) + (size_t)l * D * PLE, PLE, (r / (D / 32)) * 64, (r % (D / 32)) * 32, (r % (D / 32)) * 32, scr, lane); continue; } r -= I_PL;
        transpose_item(p.w_plg + (size_t)l * D * D, D, nullptr, 1.f, (bf16_t*)(ws + WS_WPLG) + (size_t)l * D * D, D, (r / (D / 32)) * 64, (r % (D / 32)) * 32, (r % (D / 32)) * 32, scr, lane);
    }
    float* lbs = (float*)(ws + WS_LBS);
    for (int c = wg * NTHR + tid; c < HW; c += nwg * NTHR) {
        float e[DEPTH], mx = -1e30f, sum = 0.f;
#pragma unroll
        for (int i = 0; i < DEPTH; ++i) { e[i] = p.lbp[i * HW + c]; mx = fmaxf(mx, e[i]); }
#pragma unroll
        for (int i = 0; i < DEPTH; ++i) { e[i] = __expf(e[i] - mx); sum += e[i]; }
        float acc = 0.f; lbs[c] = 0.f;
#pragma unroll
        for (int i = 1; i < DEPTH; ++i) { acc += e[i]; lbs[i * HW + c] = acc / sum; }
    }
    { bf16_t* pbf = (bf16_t*)(ws + WS_PBF);
      constexpr size_t NPP = (size_t)DEPTH * MP * PLE, NPS = (size_t)DEPTH * DECB * PLE;
      for (size_t i = ((size_t)wg * NTHR + tid) * 4; i < NPP + NPS; i += (size_t)nwg * NTHR * 4) {
          const float* src = i < NPP ? p.pp + i : p.ps + (i - NPP);
          const f32x4 v = *(const f32x4*)src; u32x2 w; w.x = pk2(v[0], v[1]); w.y = pk2(v[2], v[3]); *(u32x2*)(pbf + i) = w; } }
    bf16_t* hbf = (bf16_t*)(ws + WS_HBF); float* ssq = (float*)(ws + WS_SSQ);
    for (int row = gw; row < MT; row += NGW) {
        const float* src = row < MP ? p.xp + (size_t)row * D : p.xs + (size_t)(row - MP) * D; float s = 0.f;
#pragma unroll
        for (int j = 0; j < 8; ++j) { const f32x4 v = *(const f32x4*)(src + j * 256 + lane * 4); s += (v[0] * v[0] + v[1] * v[1]) + (v[2] * v[2] + v[3] * v[3]);
            u32x2 w; w.x = pk2(v[0], v[1]); w.y = pk2(v[2], v[3]); *(u32x2*)(hbf + (size_t)row * D + j * 256 + lane * 4) = w; }
        s = wave_sum(s);
        if (lane < SSQW) ssq[(size_t)row * SSQW + lane] = lane == 0 ? s : 0.f;
    }
}

constexpr size_t WS_T4 = WS_T32, WS_T6 = WS_T32 + (size_t)MR * D * 2;
constexpr size_t WS_PART4 = WS_PART, WS_PART6 = WS_PART + (size_t)4 * DECB * D * 4;
__device__ __forceinline__ float ssq4(const f32x4 x) { return (x[0] * x[0] + x[1] * x[1]) + (x[2] * x[2] + x[3] * x[3]); }
__device__ __forceinline__ f32x4 unpk4(const u32x2 w) { return (f32x4){__uint_as_float(w.x << 16), __uint_as_float(w.x & 0xffff0000u), __uint_as_float(w.y << 16), __uint_as_float(w.y & 0xffff0000u)}; }
template <int MODE> __device__ __forceinline__ void thin_post(unsigned char* ws, LAS unsigned char* lds, const bf16_t* hcur, const float* g1, const float* g2, const float* g3, bf16_t* hbf_dst, int wg, int nwg) {
    const int lane = tidx() & 63, wave = tidx() >> 6;
    LAS float* red = (LAS float*)lds;
    for (int r = wg; r < DECB; r += nwg) {
        const int row = MP + r, col = wave * 256 + lane * 4;
        const float* p4 = (const float*)(ws + WS_PART4) + (size_t)r * D + col; f32x4 t = *(const f32x4*)p4;
        f32x4 u = (f32x4){0.f, 0.f, 0.f, 0.f};
        if constexpr (MODE == 1) { const float* p6 = (const float*)(ws + WS_PART6) + (size_t)r * D + col; u = *(const f32x4*)p6;
#pragma unroll
            for (int ks = 1; ks < 4; ++ks) u += *(const f32x4*)(p6 + (size_t)ks * DECB * D); }
        const f32x4 h = unpk4(*(const u32x2*)(hcur + (size_t)row * D + col));
        const float s1 = wave_sum(ssq4(t)), s3 = wave_sum(ssq4(u));
        __syncthreads();
        if (lane == 0) { red[wave] = s1; red[8 + wave] = s3; }
        __syncthreads();
        float S1 = 0.f, S3 = 0.f;
#pragma unroll
        for (int k = 0; k < 8; ++k) { S1 += red[k]; S3 += red[8 + k]; }
        const float rs1 = rsqrtf(S1 * (1.f / D) + EPS);
        const f32x4 h1 = h + t * rs1 * *(const f32x4*)(g1 + col);
        if constexpr (MODE == 0) {
            const float s2 = wave_sum(ssq4(h1));
            if (lane == 0) red[16 + wave] = s2;
            __syncthreads();
            float S2 = 0.f;
#pragma unroll
            for (int k = 0; k < 8; ++k) S2 += red[16 + k];
            u32x2 w; w.x = pk2(h1[0], h1[1]); w.y = pk2(h1[2], h1[3]); *(u32x2*)((bf16_t*)(ws + WS_T4) + (size_t)row * D + col) = w;
            if (tidx() < 8) ((float*)(ws + WS_CTL))[CW_SSQ2 + (size_t)row * 8 + tidx()] = tidx() == 0 ? S2 : 0.f;
        } else {
            const f32x4 h2 = h1 + u * rsqrtf(S3 * (1.f / D) + EPS) * *(const f32x4*)(g3 + col);
            u32x2 w; w.x = pk2(h2[0], h2[1]); w.y = pk2(h2[2], h2[3]); *(u32x2*)(hbf_dst + (size_t)row * D + col) = w;
        }
    }
}

constexpr size_t OUT_HP = (size_t)MT * D;
constexpr size_t OUT_GP = OUT_HP + (size_t)DEPTH * BATCH * HH * HK * HV;
constexpr size_t OUT_HS = OUT_GP + (size_t)DEPTH * BATCH * GH * GK * GV;
constexpr size_t OUT_GS = OUT_HS + (size_t)DEPTH * DECB * HH * HK * HV;
constexpr int SQ = 272, SK = 144;
constexpr int R_QA = 0, R_PP = R_QA + 64 * SQ, R_KBT = R_PP + 64 * SK, R_DEC = R_KBT + 128 * SK, IMG_BYTES = R_DEC + 512;
constexpr int R_VT = IMG_BYTES, R_ST0 = R_VT + 64 * SK, R_ST1 = R_ST0 + 64 * SQ, R_END = R_ST1 + 64 * SQ;
constexpr int R_OSQ = R_END, R_ORS = R_OSQ + SEQ * 2 * 4, R_OEND = R_ORS + SEQ * 4;
static_assert(R_OEND <= 131072, "recurrence LDS map (head-norm tables)");
constexpr int RP_KA = IMG_BYTES, RP_SEG = RP_KA + 64 * SQ;
static_assert(R_END <= 131072 && IMG_BYTES % 256 == 0, "recurrence LDS / image map");
constexpr int NSH = BATCH * HH + BATCH * GH;
constexpr size_t WS_IMG = WS_MRG;
constexpr size_t WS_EMID = WS_IMG + (size_t)NSH * 32 * IMG_BYTES;
constexpr size_t WS_XO = WS_EMID + (size_t)NSH * 32 * 128 * 4;
static_assert(WS_XO + (size_t)NSH * 4 * SEQ * 4 <= WS_MRG + (size_t)MR * D * 2 + (size_t)MR * DFF * 2, "chunk images + head-norm exchange fit in MRG | U");
constexpr int CW_TMO = 1024 + 128;
constexpr int CW_OCNT = 231424;
static_assert((size_t)(CW_OCNT + DEPTH * NSH * 64) * 4 <= CTL_BYTES && CW_OCNT >= CW_SSQ2 + MR * 8, "head-norm counters");
typedef short bf16x8_t __attribute__((ext_vector_type(8)));
#define MFMA16(a, b, c) __builtin_amdgcn_mfma_f32_16x16x32_bf16((a), (b), (c), 0, 0, 0)

__device__ __forceinline__ void rec_prep_task(unsigned char* ws, LAS unsigned char* lds, int tkp) {
    const int tid = tidx();
    const int shg = tkp >> 5, ch = tkp & 31; const bool gla = shg >= BATCH * HH; const int sh = gla ? shg - BATCH * HH : shg;
    const int nheads = gla ? GH : HH, b = sh / nheads, head = sh % nheads, ldk = gla ? GKW : HW;
    const size_t row0 = (size_t)(b * SEQ + ch * 64);
    const bf16_t* qp = (const bf16_t*)(ws + (gla ? WS_QG : WS_QH)) + row0 * ldk + head * 128;
    const bf16_t* kp = (const bf16_t*)(ws + (gla ? WS_KG : WS_KH)) + row0 * ldk + head * 128;
    const float* gp = (const float*)(ws + (gla ? WS_LOGA : WS_LOGF)) + row0 * ldk + head * 128;
    unsigned char* img = ws + WS_IMG + (size_t)tkp * IMG_BYTES;
    const int c = tid & 127, tq = tid >> 7;
    float gr[16]; bf16_t qr[16], kr[16];
#pragma unroll
    for (int i = 0; i < 16; ++i) { const size_t t = (size_t)(tq * 16 + i); gr[i] = gp[t * ldk + c]; qr[i] = qp[t * ldk + c]; kr[i] = kp[t * ldk + c]; }
    float pf[16]; float run = 0.f;
#pragma unroll
    for (int i = 0; i < 16; ++i) { run += gr[i]; pf[i] = run; }
    __syncthreads();
    ((LAS float*)(lds + RP_SEG))[tq * 128 + c] = run;
    __syncthreads();
    const float s0 = ((LAS float*)(lds + RP_SEG))[c], s1 = ((LAS float*)(lds + RP_SEG))[128 + c], s2 = ((LAS float*)(lds + RP_SEG))[256 + c], s3 = ((LAS float*)(lds + RP_SEG))[384 + c];
    const float off = tq == 0 ? 0.f : (tq == 1 ? s0 : (tq == 2 ? s0 + s1 : s0 + s1 + s2));
    const float bmid = s0 + s1, blast = (s0 + s1) + (s2 + s3);
    const float Elm = __expf(blast - bmid);
    if (tq == 0) { ((LAS float*)(lds + R_DEC))[c] = __expf(blast); ((float*)(ws + WS_EMID))[(size_t)tkp * 128 + c] = __expf(bmid); }
    float kb[16];
#pragma unroll
    for (int i = 0; i < 16; ++i) {
        const int t = tq * 16 + i;
        const float x = clampf(off + pf[i] - bmid, -60.f, 60.f);
        const float e1 = __expf(x), r1 = __builtin_amdgcn_rcpf(e1);
        const float qa = bf2f(qr[i]) * e1, ka = bf2f(kr[i]) * r1;
        *(LAS bf16_t*)(lds + R_QA + t * SQ + c * 2) = (bf16_t)pk2(qa, 0.f);
        *(LAS bf16_t*)(lds + RP_KA + t * SQ + c * 2) = (bf16_t)pk2(ka, 0.f);
        kb[i] = ka * Elm;
    }
    { u32x4 w0, w1; w0.x = pk2(kb[0], kb[1]); w0.y = pk2(kb[2], kb[3]); w0.z = pk2(kb[4], kb[5]); w0.w = pk2(kb[6], kb[7]);
      w1.x = pk2(kb[8], kb[9]); w1.y = pk2(kb[10], kb[11]); w1.z = pk2(kb[12], kb[13]); w1.w = pk2(kb[14], kb[15]);
      *(LAS u32x4*)(lds + R_KBT + c * SK + tq * 32) = w0; *(LAS u32x4*)(lds + R_KBT + c * SK + tq * 32 + 16) = w1; }
    __syncthreads();
    {
        const int lane = tid & 63, w = tid >> 6, fr = lane & 15, fq = lane >> 4, ti = w >> 1, vi = w & 1;
        bf16x8_t qf[4];
#pragma unroll
        for (int kk = 0; kk < 4; ++kk) qf[kk] = *(const LAS bf16x8_t*)(lds + R_QA + (ti * 16 + fr) * SQ + kk * 64 + fq * 16);
#pragma unroll
        for (int sj = 0; sj < 2; ++sj) { const int si = 2 * vi + sj; f32x4 acc = (f32x4){0.f, 0.f, 0.f, 0.f};
#pragma unroll
            for (int kk = 0; kk < 4; ++kk) { const bf16x8_t a = *(const LAS bf16x8_t*)(lds + RP_KA + (si * 16 + fr) * SQ + kk * 64 + fq * 16); acc = MFMA16(a, qf[kk], acc); }
            const int t = ti * 16 + fr, sb = si * 16 + fq * 4;
            u32x2 wv; wv.x = pk2(sb <= t ? acc[0] : 0.f, sb + 1 <= t ? acc[1] : 0.f); wv.y = pk2(sb + 2 <= t ? acc[2] : 0.f, sb + 3 <= t ? acc[3] : 0.f);
            *(LAS u32x2*)(lds + R_PP + t * SK + sb * 2) = wv; }
    }
    __syncthreads();
    for (int i = tid; i < IMG_BYTES / 16; i += NTHR) *(u32x4*)(img + (size_t)i * 16) = *(const LAS u32x4*)(lds + i * 16);
}

__device__ __forceinline__ void rec_loop_task(const P& p, unsigned char* ws, int l, LAS unsigned char* lds, int tk) {
    const int tid = tidx(), lane = tid & 63, w = __builtin_amdgcn_readfirstlane(tid >> 6), fr = lane & 15, fq = lane >> 4;
    const int xcd = tk & 7, jx = tk >> 3;
    const bool gla = jx >= 8;
    const int sh = gla ? xcd + 8 * ((jx - 8) >> 2) : xcd + 8 * (jx >> 1), vs = gla ? ((jx - 8) & 3) : (jx & 1), V = gla ? GV : HV, nheads = gla ? GH : HH, b = sh / nheads, head = sh % nheads;
    const int shg = gla ? sh + BATCH * HH : sh;
    const unsigned char* img0 = ws + WS_IMG + (size_t)shg * 32 * IMG_BYTES;
    const float* em0 = (const float*)(ws + WS_EMID) + (size_t)shg * 32 * 128 + (w >> 1) * 32 + fq * 4;
    const bf16_t* vp = (const bf16_t*)(ws + (gla ? WS_VG : WS_VH)) + (size_t)(b * SEQ) * 1024 + head * V + vs * 64;
    float* op = (float*)(ws + WS_T32) + (size_t)(b * SEQ) * D + (gla ? 1024 : 0) + head * V + vs * 64;
    float* sp = p.out + (gla ? OUT_GP : OUT_HP) + (size_t)l * BATCH * nheads * 128 * V + ((size_t)sh * 128) * V + vs * 64;
    const int ti = w >> 1, vi = w & 1;
    f32x4 Sacc[2][2];
#pragma unroll
    for (int cj = 0; cj < 2; ++cj)
#pragma unroll
        for (int oj = 0; oj < 2; ++oj) Sacc[cj][oj] = (f32x4){0.f, 0.f, 0.f, 0.f};
    __syncthreads();
    for (int i = tid; i < 64 * SQ / 4; i += NTHR) ((LAS unsigned*)(lds + R_ST0))[i] = 0u;
    constexpr int NCORE = IMG_BYTES / 16;
    u32x4 pre[7], pre2[7]; f32x4 em1[2], em2[2];
    int pidx[6];
#pragma unroll
    for (int i = 0; i < 6; ++i) { const int pi_ = tid + i * NTHR; pidx[i] = pi_ < NCORE ? pi_ : NCORE - 1; }
    const int vt_t = ((tid >> 6) & 1) * 32 + (tid & 31), vt_q = (tid >> 7) * 2 + ((tid >> 5) & 1);
#define REC_FETCH(pre, em, chn) do { const unsigned char* im_ = img0 + (size_t)(chn) * IMG_BYTES; \
        _Pragma("unroll") for (int i = 0; i < 6; ++i) pre[i] = *(const u32x4*)(im_ + (size_t)pidx[i] * 16);     \
        pre[6] = *(const u32x4*)(vp + (size_t)((chn) * 64 + vt_t) * 1024 + vt_q * 8); \
        { const float* e_ = em0 + (size_t)((chn) + 1 < SEQ / 64 ? (chn) + 1 : (chn)) * 128; em[0] = *(const f32x4*)e_; em[1] = *(const f32x4*)(e_ + 16); } } while (0)
#define REC_STAGE(pre) do { _Pragma("unroll") for (int i = 0; i < 6; ++i) *(LAS u32x4*)(lds + pidx[i] * 16) = pre[i]; \
        { const unsigned wv_[4] = {pre[6].x, pre[6].y, pre[6].z, pre[6].w}; \
          _Pragma("unroll") for (int i = 0; i < 4; ++i) { *(LAS bf16_t*)(lds + R_VT + (vt_q * 8 + 2 * i) * SK + vt_t * 2) = (bf16_t)(wv_[i] & 0xffffu); *(LAS bf16_t*)(lds + R_VT + (vt_q * 8 + 2 * i + 1) * SK + vt_t * 2) = (bf16_t)(wv_[i] >> 16); } } } while (0)
    REC_FETCH(pre, em1, 0); REC_FETCH(pre2, em2, 1);
    for (int ch = 0; ch < SEQ / 64; ch += 2) {
#pragma unroll
      for (int half = 0; half < 2; ++half) {
        const int st_rd = half ? R_ST1 : R_ST0, st_wr = half ? R_ST0 : R_ST1;
        __syncthreads();
        f32x4 emn[2];
        if (half == 0) { REC_STAGE(pre); emn[0] = em1[0]; emn[1] = em1[1]; REC_FETCH(pre, em1, (ch + 2 < SEQ / 64 ? ch + 2 : SEQ / 64 - 1)); }
        else { REC_STAGE(pre2); emn[0] = em2[0]; emn[1] = em2[1]; REC_FETCH(pre2, em2, (ch + 3 < SEQ / 64 ? ch + 3 : SEQ / 64 - 1)); }
        __syncthreads();
        f32x4 oacc[2] = {(f32x4){0.f, 0.f, 0.f, 0.f}, (f32x4){0.f, 0.f, 0.f, 0.f}};
        __builtin_amdgcn_s_setprio(1);
#pragma unroll
        for (int kk = 0; kk < 4; ++kk) { const bf16x8_t qf = *(const LAS bf16x8_t*)(lds + R_QA + (ti * 16 + fr) * SQ + kk * 64 + fq * 16);
#pragma unroll
            for (int oj = 0; oj < 2; ++oj) { const bf16x8_t bb = *(const LAS bf16x8_t*)(lds + st_rd + ((2 * vi + oj) * 16 + fr) * SQ + kk * 64 + fq * 16); oacc[oj] = MFMA16(bb, qf, oacc[oj]); } }
        bf16x8_t vf[2][2];
#pragma unroll
        for (int oj = 0; oj < 2; ++oj)
#pragma unroll
            for (int kk = 0; kk < 2; ++kk) vf[oj][kk] = *(const LAS bf16x8_t*)(lds + R_VT + ((2 * vi + oj) * 16 + fr) * SK + kk * 64 + fq * 16);
#pragma unroll
        for (int kk = 0; kk < 2; ++kk) { const bf16x8_t a = *(const LAS bf16x8_t*)(lds + R_PP + (ti * 16 + fr) * SK + kk * 64 + fq * 16);
#pragma unroll
            for (int oj = 0; oj < 2; ++oj) oacc[oj] = MFMA16(vf[oj][kk], a, oacc[oj]); }
#pragma unroll
        for (int cj = 0; cj < 2; ++cj) { const int ct = 2 * ti + cj;
            const f32x4 dc = *(const LAS f32x4*)(lds + R_DEC + (ct * 16 + fq * 4) * 4);
#pragma unroll
            for (int oj = 0; oj < 2; ++oj) Sacc[cj][oj] = Sacc[cj][oj] * dc;
#pragma unroll
            for (int kk = 0; kk < 2; ++kk) { const bf16x8_t kf = *(const LAS bf16x8_t*)(lds + R_KBT + (ct * 16 + fr) * SK + kk * 64 + fq * 16);
#pragma unroll
                for (int oj = 0; oj < 2; ++oj) Sacc[cj][oj] = MFMA16(kf, vf[oj][kk], Sacc[cj][oj]); } }
        __builtin_amdgcn_s_setprio(0);
#pragma unroll
        for (int oj = 0; oj < 2; ++oj) *(f32x4*)(op + (size_t)((ch + half) * 64 + ti * 16 + fr) * D + (2 * vi + oj) * 16 + fq * 4) = oacc[oj];
        { const f32x4 q2 = oacc[0] * oacc[0] + oacc[1] * oacc[1]; float x = (q2[0] + q2[1]) + (q2[2] + q2[3]);
          x += __shfl_xor(x, 16); x += __shfl_xor(x, 32);
          if (fq == 0) ((LAS float*)(lds + R_OSQ))[((ch + half) * 64 + ti * 16 + fr) * 2 + vi] = x; }
#pragma unroll
        for (int cj = 0; cj < 2; ++cj)
#pragma unroll
            for (int oj = 0; oj < 2; ++oj) { u32x2 wv; wv.x = pk2(Sacc[cj][oj][0] * emn[cj][0], Sacc[cj][oj][1] * emn[cj][1]); wv.y = pk2(Sacc[cj][oj][2] * emn[cj][2], Sacc[cj][oj][3] * emn[cj][3]);
                *(LAS u32x2*)(lds + st_wr + ((2 * vi + oj) * 16 + fr) * SQ + ((2 * ti + cj) * 16 + fq * 4) * 2) = wv; }
      }
    }
#undef REC_FETCH
#undef REC_STAGE
#pragma unroll
    for (int cj = 0; cj < 2; ++cj)
#pragma unroll
        for (int oj = 0; oj < 2; ++oj)
#pragma unroll
            for (int j = 0; j < 4; ++j) sp[(size_t)((2 * ti + cj) * 16 + fq * 4 + j) * V + (2 * vi + oj) * 16 + fr] = Sacc[cj][oj][j];
    const int nsl = V / 64;
    float* xo = (float*)(ws + WS_XO) + (size_t)shg * 4 * SEQ;
    unsigned* ocnt = (unsigned*)(ws + WS_CTL) + CW_OCNT + (l * NSH + shg) * 64;
    unsigned* tmo = (unsigned*)(ws + WS_CTL) + CW_TMO;
    __syncthreads();
    { const f32x4 a = *(const LAS f32x4*)(lds + R_OSQ + tid * 32), bq = *(const LAS f32x4*)(lds + R_OSQ + tid * 32 + 16);
      float* slot = xo + (size_t)vs * SEQ + tid * 4;
      __hip_atomic_store(slot + 0, a[0] + a[1], __ATOMIC_RELAXED, __HIP_MEMORY_SCOPE_AGENT); __hip_atomic_store(slot + 1, a[2] + a[3], __ATOMIC_RELAXED, __HIP_MEMORY_SCOPE_AGENT);
      __hip_atomic_store(slot + 2, bq[0] + bq[1], __ATOMIC_RELAXED, __HIP_MEMORY_SCOPE_AGENT); __hip_atomic_store(slot + 3, bq[2] + bq[3], __ATOMIC_RELAXED, __HIP_MEMORY_SCOPE_AGENT); }
    asm volatile("s_waitcnt vmcnt(0)" ::: "memory");
    __syncthreads();
    if (w == 0) {
        if (lane == 0) __hip_atomic_fetch_add(ocnt, 1u, __ATOMIC_RELAXED, __HIP_MEMORY_SCOPE_AGENT);
        unsigned sp_ = 0u;
        while ((unsigned)__builtin_amdgcn_readfirstlane(__hip_atomic_load(ocnt, __ATOMIC_RELAXED, __HIP_MEMORY_SCOPE_AGENT)) < (unsigned)nsl) {
            __builtin_amdgcn_s_sleep(1);
            if ((++sp_ & 255u) == 0u) { if (__hip_atomic_load(tmo, __ATOMIC_RELAXED, __HIP_MEMORY_SCOPE_AGENT)) break; if (sp_ > (1u << 18)) { if (lane == 0) atomicAdd(tmo, 1u); break; } } }
        __builtin_amdgcn_fence(__ATOMIC_ACQUIRE, "agent"); }
    __syncthreads();
    { f32x4 qa, qb, qc, qd; const float* x0 = xo + tid * 4;
      ld_sc1_4x4(x0, x0 + SEQ, x0 + 2 * SEQ, x0 + 3 * SEQ, qa, qb, qc, qd);
      float s4[4];
#pragma unroll
      for (int j = 0; j < 4; ++j) s4[j] = (qa[j] + qb[j]) + (nsl > 2 ? qc[j] + qd[j] : 0.f);
      const float iv = gla ? (1.f / GV) : (1.f / HV);
      *(LAS f32x4*)(lds + R_ORS + tid * 16) = (f32x4){rsqrtf(s4[0] * iv + EPS), rsqrtf(s4[1] * iv + EPS), rsqrtf(s4[2] * iv + EPS), rsqrtf(s4[3] * iv + EPS)}; }
    __syncthreads();
    { const int c4 = (tid & 15) * 4, r0 = tid >> 4;
      const f32x4 gn4 = *(const f32x4*)((gla ? p.gln + l * GV : p.hgn + l * HV) + vs * 64 + c4);
      const bf16_t* gate = (const bf16_t*)(ws + (gla ? WS_RG : WS_GHG)) + (size_t)(b * SEQ) * 1024 + head * V + vs * 64 + c4;
      bf16_t* og = (bf16_t*)(ws + WS_OG) + (size_t)(b * SEQ) * D + (gla ? 1024 : 0) + head * V + vs * 64 + c4;
      const float* orow = op + c4;
#pragma nounroll
      for (int rb = 0; rb < SEQ; rb += 256) {
          f32x4 ov[8]; u32x2 gw[8];
#pragma unroll
          for (int i = 0; i < 8; ++i) { const int r = rb + i * 32 + r0; ov[i] = *(const f32x4*)(orow + (size_t)r * D); gw[i] = *(const u32x2*)(gate + (size_t)r * 1024); }
#pragma unroll
          for (int i = 0; i < 8; ++i) { const int r = rb + i * 32 + r0; const float rs = ((const LAS float*)(lds + R_ORS))[r];
              const float g0 = __uint_as_float(gw[i].x << 16), g1 = __uint_as_float(gw[i].x & 0xffff0000u), g2 = __uint_as_float(gw[i].y << 16), g3 = __uint_as_float(gw[i].y & 0xffff0000u);
              u32x2 wv; wv.x = pk2(ov[i][0] * rs * gn4[0] * g0, ov[i][1] * rs * gn4[1] * g1); wv.y = pk2(ov[i][2] * rs * gn4[2] * g2, ov[i][3] * rs * gn4[3] * g3);
              *(u32x2*)(og + (size_t)r * D) = wv; } } }
    __syncthreads();
}

template <int V, bool GLA> __device__ __forceinline__ void rec_sample_item(const P& p, unsigned char* ws, int l, LAS unsigned char* lds, int b, int head) {
    constexpr int nheads = GLA ? GH : HH, ldk = GLA ? GKW : HW, NV4 = V / 4, NCG = NTHR / NV4, CPG = 128 / NCG;
    const int tid = tidx(); const size_t row = (size_t)(MP + b);
    LAS float* DQ = (LAS float*)lds; LAS float* RED = (LAS float*)(lds + 2048);
    __syncthreads();
    if (tid < 128) {
        DQ[tid] = __expf(((const float*)(ws + (GLA ? WS_LOGA : WS_LOGF)))[row * ldk + head * 128 + tid]);
        DQ[128 + tid] = bf2f(((const bf16_t*)(ws + (GLA ? WS_KG : WS_KH)))[row * ldk + head * 128 + tid]);
        DQ[256 + tid] = bf2f(((const bf16_t*)(ws + (GLA ? WS_QG : WS_QH)))[row * ldk + head * 128 + tid]);
    }
    __syncthreads();
    const int v4 = tid % NV4, cg = tid / NV4;
    const u32x2 vw = *(const u32x2*)((const bf16_t*)(ws + (GLA ? WS_VG : WS_VH)) + row * 1024 + head * V + v4 * 4);
    const f32x4 vv = (f32x4){__uint_as_float(vw.x << 16), __uint_as_float(vw.x & 0xffff0000u), __uint_as_float(vw.y << 16), __uint_as_float(vw.y & 0xffff0000u)};
    const size_t sbase = ((size_t)l * DECB * nheads + (size_t)b * nheads + head) * 128 * V;
    const float* s0 = (GLA ? p.stg : p.sth) + sbase; float* so = p.out + (GLA ? OUT_GS : OUT_HS) + sbase;
    f32x4 oacc = (f32x4){0.f, 0.f, 0.f, 0.f};
    f32x4 sv[CPG];
#pragma unroll
    for (int i = 0; i < CPG; ++i) sv[i] = __builtin_nontemporal_load((const f32x4*)(s0 + (size_t)(cg * CPG + i) * V + v4 * 4));
#pragma unroll
    for (int i = 0; i < CPG; ++i) { const int cc = cg * CPG + i; const f32x4 sn = sv[i] * DQ[cc] + vv * DQ[128 + cc]; __builtin_nontemporal_store(sn, (f32x4*)(so + (size_t)cc * V + v4 * 4)); oacc += sn * DQ[256 + cc]; }
    *(LAS f32x4*)(RED + cg * V + v4 * 4) = oacc;
    __syncthreads();
    float s = 0.f;
    if (tid < V) {
#pragma unroll
        for (int g = 0; g < NCG; ++g) s += RED[g * V + tid]; }
    { float q = wave_sum(tid < V ? s * s : 0.f);
      __syncthreads();
      if ((tid & 63) == 0) DQ[384 + (tid >> 6)] = q;
      __syncthreads();
      float tot = 0.f;
#pragma unroll
      for (int k = 0; k < V / 64; ++k) tot += DQ[384 + k];
      if (tid < V) { const float rs = rsqrtf(tot * (1.f / V) + EPS);
          const float gn = (GLA ? p.gln + l * GV : p.hgn + l * HV)[tid];
          const float gt = bf2f(((const bf16_t*)(ws + (GLA ? WS_RG : WS_GHG)))[row * 1024 + head * V + tid]);
          ((bf16_t*)(ws + WS_OG))[row * D + (GLA ? 1024 : 0) + head * V + tid] = (bf16_t)pk2(s * rs * gn * gt, 0.f); } }
}
constexpr int REP_SST = 1, REP_LOOP = 1;
#ifndef LK_ITEMS
#define LK_ITEMS 0
#endif
__device__ __forceinline__ void phase_rec(const P& p, unsigned char* ws, int l, LAS unsigned char* lds, int wg, int nwg) {
    int lrank = wg, nloop = nwg, srank = wg, nstr = nwg;
    const bool split = nwg >= 16;
    if (split) { const int grp = wg >> 3, ngrp = (nwg + 7) >> 3, nlg = (ngrp + 1) >> 1;
        const int full_l = nlg * 8 - ((ngrp & 1) ? (ngrp * 8 - nwg) : 0), full_s = nwg - full_l;
        nloop = full_l; nstr = full_s; lrank = (grp >> 1) * 8 + (wg & 7); srank = (grp >> 1) * 8 + (wg & 7);
        if (grp & 1) lrank = 1 << 30; else srank = 1 << 30; }
    for (int rl = 0; rl < REP_LOOP; ++rl) for (int tk = lrank; tk < 128; tk += nloop) rec_loop_task(p, ws, l, lds, tk);
    const int nlk = split ? LK_ITEMS * nloop : 0;
    for (int rs = 0; rs < REP_SST; ++rs) {
    if (split) for (int it = lrank; it < nlk; it += nloop) rec_sample_item<HV, false>(p, ws, l, lds, it >> 3, it & 7);
    for (int it = nlk + srank; it < DECB * HH; it += nstr) rec_sample_item<HV, false>(p, ws, l, lds, it >> 3, it & 7);
    for (int it = srank; it < DECB * GH; it += nstr) rec_sample_item<GV, true>(p, ws, l, lds, it >> 2, it & 3); }
}


constexpr int SG32_LD = 36;
template <int MODE, int NST, class F>
__device__ __forceinline__ void sample_gemm32(const bf16_t* A, int lda, const bf16_t* Bt, int ldb, int N, const F& f, float* aux, LAS unsigned char* lds, int wg, int nwg) {
    const int tid = tidx(), lane = tid & 63, w = __builtin_amdgcn_readfirstlane(tid >> 6), fr = lane & 15, fq = lane >> 4;
    constexpr int Kw = NST * 32;
    const int nitems = (N / 32) * 4;
    LAS float* tile = (LAS float*)lds;
    for (int item = wg; item < nitems; item += nwg) {
        const int rb = item & 3, cb = item >> 2;
        const char* abase = (const char*)(A + (size_t)(rb * 32) * lda + w * Kw);
        const char* bbase = (const char*)(Bt + (size_t)(cb * 32) * ldb + w * Kw);
        unsigned aoff[2], boff[2];
#pragma unroll
        for (int t2 = 0; t2 < 2; ++t2) { aoff[t2] = (unsigned)((t2 * 16 + fr) * lda + fq * 8) * 2u; boff[t2] = (unsigned)((t2 * 16 + fr) * ldb + fq * 8) * 2u; }
        bf16x8_t av[NST][2], bv[NST][2];
#pragma unroll
        for (int st = 0; st < NST; ++st)
#pragma unroll
            for (int t2 = 0; t2 < 2; ++t2) { av[st][t2] = *(const bf16x8_t*)(abase + st * 64 + aoff[t2]); bv[st][t2] = *(const bf16x8_t*)(bbase + st * 64 + boff[t2]); }
        f32x4 acc[2][2];
#pragma unroll
        for (int mt = 0; mt < 2; ++mt)
#pragma unroll
            for (int nt = 0; nt < 2; ++nt) acc[mt][nt] = (f32x4){0.f, 0.f, 0.f, 0.f};
#pragma unroll
        for (int st = 0; st < NST; ++st)
#pragma unroll
            for (int mt = 0; mt < 2; ++mt)
#pragma unroll
                for (int nt = 0; nt < 2; ++nt) acc[mt][nt] = MFMA16(bv[st][nt], av[st][mt], acc[mt][nt]);
        __syncthreads();
        LAS float* tk = tile + w * (32 * SG32_LD);
#pragma unroll
        for (int mt = 0; mt < 2; ++mt)
#pragma unroll
            for (int nt = 0; nt < 2; ++nt) *(LAS f32x4*)(tk + (mt * 16 + fr) * SG32_LD + nt * 16 + fq * 4) = acc[mt][nt];
        __syncthreads();
        if (tid < 128) {
            const int r = tid >> 2, cq = (tid & 3) * 8;
            f32x4 x0 = *(const LAS f32x4*)(tile + r * SG32_LD + cq), x1 = *(const LAS f32x4*)(tile + r * SG32_LD + cq + 4);
#pragma unroll
            for (int q = 1; q < 8; ++q) { x0 += *(const LAS f32x4*)(tile + q * (32 * SG32_LD) + r * SG32_LD + cq); x1 += *(const LAS f32x4*)(tile + q * (32 * SG32_LD) + r * SG32_LD + cq + 4); }
            const float v[8] = {x0[0], x0[1], x0[2], x0[3], x1[0], x1[1], x1[2], x1[3]};
            const int row = MP + rb * 32 + r;
            if constexpr (MODE == 0) f.apply8(row, cb * 32 + cq, v, f.rowctx(row));
            else { float ssum = f.apply8s(row, cb * 32 + cq, v); ssum += __shfl_xor(ssum, 1); ssum += __shfl_xor(ssum, 2); if ((tid & 3) == 0) aux[(size_t)row * SSQW + cb] = ssum; }
        }
    }
    __syncthreads();
}

constexpr int SG64_LD = 68;
#ifndef SG64_SB
#define SG64_SB 2
#endif
static_assert(8 * 64 * SG64_LD * 4 <= LDS_BYTES - 2048, "sample GEMM (64x64) LDS tiles");
template <int MODE, int KSPLIT, class F>
__device__ __forceinline__ void sample_gemm64(const bf16_t* A, int lda, const bf16_t* Bt, int ldb, int N, int K, const F& f, float* aux, LAS unsigned char* lds, int wg, int nwg) {
    const int tid = tidx(), lane = tid & 63, w = __builtin_amdgcn_readfirstlane(tid >> 6), fr = lane & 15, fq = lane >> 4;
    const int Kc = K / KSPLIT, Kw = Kc / 8, nbatch = Kw / (32 * SG64_SB), nitems = 2 * (N / 64) * KSPLIT;
    LAS float* tile = (LAS float*)lds;
    for (int item = wg; item < nitems; item += nwg) {
        const int rb = item & 1, rest = item >> 1, ks = rest % KSPLIT, cb = rest / KSPLIT;
        const char* abase = (const char*)(A + (size_t)(rb * 64) * lda + ks * Kc + w * Kw);
        const char* bbase = (const char*)(Bt + (size_t)(cb * 64) * ldb + ks * Kc + w * Kw);
        unsigned aoff[4], boff[4];
#pragma unroll
        for (int t4 = 0; t4 < 4; ++t4) { aoff[t4] = (unsigned)((t4 * 16 + fr) * lda + fq * 8) * 2u; boff[t4] = (unsigned)((t4 * 16 + fr) * ldb + fq * 8) * 2u; }
        f32x4 acc[4][4];
#pragma unroll
        for (int mt = 0; mt < 4; ++mt)
#pragma unroll
            for (int nt = 0; nt < 4; ++nt) acc[mt][nt] = (f32x4){0.f, 0.f, 0.f, 0.f};
#pragma nounroll
        for (int b = 0; b < nbatch; ++b) {
            bf16x8_t av[SG64_SB][4], bv[SG64_SB][4];
            const char* ab_ = abase + b * (64 * SG64_SB); const char* bb_ = bbase + b * (64 * SG64_SB);
#pragma unroll
            for (int st = 0; st < SG64_SB; ++st)
#pragma unroll
                for (int t4 = 0; t4 < 4; ++t4) { av[st][t4] = *(const bf16x8_t*)(ab_ + st * 64 + aoff[t4]); bv[st][t4] = *(const bf16x8_t*)(bb_ + st * 64 + boff[t4]); }
#pragma unroll
            for (int st = 0; st < SG64_SB; ++st)
#pragma unroll
                for (int mt = 0; mt < 4; ++mt)
#pragma unroll
                    for (int nt = 0; nt < 4; ++nt) acc[mt][nt] = MFMA16(bv[st][nt], av[st][mt], acc[mt][nt]);
        }
        __syncthreads();
        LAS float* tk = tile + w * (64 * SG64_LD);
#pragma unroll
        for (int mt = 0; mt < 4; ++mt)
#pragma unroll
            for (int nt = 0; nt < 4; ++nt) *(LAS f32x4*)(tk + (mt * 16 + fr) * SG64_LD + nt * 16 + fq * 4) = acc[mt][nt];
        __syncthreads();
        const int r = tid >> 3, cq = (tid & 7) * 8;
        f32x4 x0 = *(const LAS f32x4*)(tile + r * SG64_LD + cq), x1 = *(const LAS f32x4*)(tile + r * SG64_LD + cq + 4);
#pragma unroll
        for (int q = 1; q < 8; ++q) { x0 += *(const LAS f32x4*)(tile + q * (64 * SG64_LD) + r * SG64_LD + cq); x1 += *(const LAS f32x4*)(tile + q * (64 * SG64_LD) + r * SG64_LD + cq + 4); }
        const float v[8] = {x0[0], x0[1], x0[2], x0[3], x1[0], x1[1], x1[2], x1[3]};
        const int row = MP + rb * 64 + r, col = cb * 64 + cq;
        if constexpr (MODE == 0) f.apply8(row, col, v, f.rowctx(row));
        else { float* dst = aux + ((size_t)ks * DECB + (row - MP)) * N + col; *(f32x4*)dst = x0; *(f32x4*)(dst + 4) = x1; }
    }
    __syncthreads();
}

#define XB_TMO      128
#define XB_XCNT(j)  (256  + 64 * (j))
#define XB_XSUB(j)  (1280 + 64 * (j))
#define XB_XGEN(j)  (2304 + 64 * (j))
#define XB_TOP      3328
#define XB_TOPGEN   3392
#define XCD_BAR_WORDS 3456
#define XB_SPIN_CAP (1u << 18)
__device__ __forceinline__ unsigned xb_ld(unsigned* p)              { return __hip_atomic_load(p, __ATOMIC_RELAXED, __HIP_MEMORY_SCOPE_AGENT); }
__device__ __forceinline__ unsigned xb_add(unsigned* p, unsigned v) { return __hip_atomic_fetch_add(p, v, __ATOMIC_RELAXED, __HIP_MEMORY_SCOPE_AGENT); }
__device__ __forceinline__ unsigned xb_xcc_id() { return (unsigned)__builtin_amdgcn_s_getreg((3 << 11) | 20) & 0xFu; }
#define XB_SPIN(cond, bar) do { unsigned _sp = 0; while (cond) { __builtin_amdgcn_s_sleep(1); \
    if ((++_sp & 255u) == 0u) { if (xb_ld(&(bar)[XB_TMO])) break; if (_sp > XB_SPIN_CAP) { atomicAdd(&(bar)[XB_TMO], 1u); break; } } } } while (0)
struct XcdBarrier { unsigned* bar; unsigned x; volatile LAS unsigned* st; };
__device__ __forceinline__ XcdBarrier xcd_barrier_post(unsigned* bar, volatile LAS unsigned* st) {
    XcdBarrier b; b.bar = bar; b.x = xb_xcc_id(); b.st = st;
    if (threadIdx.x == 0) (void)xb_add(&bar[XB_XCNT(b.x)], 1u);
    return b;
}
__device__ __forceinline__ void xcd_barrier_complete(unsigned* bar, unsigned x, unsigned& nloc, unsigned& nx) {
    const unsigned G = gridDim.x * gridDim.y * gridDim.z;
    unsigned sum, cnt, mine, sp = 0u;
    for (;;) {
        sum = 0u; cnt = 0u; mine = 0u;
#pragma unroll
        for (unsigned j = 0; j < 16; ++j) { const unsigned c = xb_ld(&bar[XB_XCNT(j)]); sum += c; cnt += (c > 0u) ? 1u : 0u; mine = (j == x) ? c : mine; }
        if (sum == G) break;
        __builtin_amdgcn_s_sleep(1);
        if ((++sp & 255u) == 0u) { if (xb_ld(&bar[XB_TMO])) break; if (sp > XB_SPIN_CAP) { atomicAdd(&bar[XB_TMO], 1u); break; } }
    }
    nloc = mine > 0u ? mine : 1u; nx = cnt > 0u ? cnt : 1u;
}
__device__ __forceinline__ void xcd_barrier(const XcdBarrier& b) {
    asm volatile("s_waitcnt vmcnt(0)" ::: "memory");
    __syncthreads();
    if (threadIdx.x == 0) {
        unsigned* bar = b.bar;
        __builtin_amdgcn_s_waitcnt(0);
        unsigned nloc = b.st[0], nx = b.st[1];
        if (nloc == 0u) { xcd_barrier_complete(bar, b.x, nloc, nx); b.st[0] = nloc; b.st[1] = nx; }
        const unsigned old = xb_add(&bar[XB_XSUB(b.x)], 1u);
        const unsigned gen = old / nloc;
        if (old + 1u == (gen + 1u) * nloc) {
            __builtin_amdgcn_fence(__ATOMIC_RELEASE, "agent");
            asm volatile("s_waitcnt vmcnt(0)" ::: "memory");
            const unsigned og = xb_add(&bar[XB_TOP], 1u);
            const unsigned tg = og / nx;
            if (og + 1u == (tg + 1u) * nx) xb_add(&bar[XB_TOPGEN], 1u);
            else XB_SPIN(xb_ld(&bar[XB_TOPGEN]) == tg, bar);
            __builtin_amdgcn_fence(__ATOMIC_ACQUIRE, "agent");
            xb_add(&bar[XB_XGEN(b.x)], 1u);
            asm volatile("s_waitcnt vmcnt(0)" ::: "memory");
        } else {
            XB_SPIN(xb_ld(&bar[XB_XGEN(b.x)]) == gen, bar);
            __builtin_amdgcn_fence(__ATOMIC_ACQUIRE, "agent");
            asm volatile("s_waitcnt vmcnt(0)" ::: "memory");
        }
    }
    __syncthreads();
}


constexpr int LDS_P_OFF = LDS_BYTES - 2048 + 256;
constexpr int RST_OFF = 131072;
static_assert(RST_OFF + 4 * 256 * 4 + 16 <= LDS_BYTES - 2048, "rstd table");
__device__ __forceinline__ const float* lds_ptr(LAS unsigned char* lds, int i) {
    const unsigned lo = *(LAS const unsigned*)(lds + LDS_P_OFF + 8 * i), hi = *(LAS const unsigned*)(lds + LDS_P_OFF + 8 * i + 4);
    return (const float*)(const __attribute__((address_space(1))) float*)(((unsigned long long)(unsigned)__builtin_amdgcn_readfirstlane((int)hi) << 32) | (unsigned)__builtin_amdgcn_readfirstlane((int)lo));
}
__device__ __forceinline__ P load_P(LAS unsigned char* lds) {
    P p;
    p.xp = lds_ptr(lds, 0); p.xs = lds_ptr(lds, 1); p.pp = lds_ptr(lds, 2); p.ps = lds_ptr(lds, 3); p.sth = lds_ptr(lds, 4); p.stg = lds_ptr(lds, 5);
    p.n_pre_mix = lds_ptr(lds, 6); p.n_post_mix = lds_ptr(lds, 7); p.n_pre_ffn = lds_ptr(lds, 8); p.n_post_ffn = lds_ptr(lds, 9); p.w_in = lds_ptr(lds, 10); p.lbp = lds_ptr(lds, 11);
    p.hgn = lds_ptr(lds, 12); p.w_hup = lds_ptr(lds, 13); p.wgg = lds_ptr(lds, 14); p.bgg = lds_ptr(lds, 15); p.gln = lds_ptr(lds, 16); p.w_gup = lds_ptr(lds, 17);
    p.w_out = lds_ptr(lds, 18); p.w_ff1 = lds_ptr(lds, 19); p.w_ff2 = lds_ptr(lds, 20); p.w_ple = lds_ptr(lds, 21); p.w_plg = lds_ptr(lds, 22);
    p.out = (float*)lds_ptr(lds, 23); p.ws = (unsigned char*)lds_ptr(lds, 24);
    return p;
}

constexpr int LDSCTL_OFF = LDS_BYTES - 2048;
constexpr int CW_BAR = 1024;
static_assert(CW_TMO == CW_BAR + XB_TMO, "timeout word index");
constexpr int REP_PRO = 1, REP_GEMM = 1, REP_REC = 1, REP_ONORM = 1, REP_BAR = 1, REP_GS = 1, REP_POST = 1, REP_P7 = 1, REP_PREP = 1;
constexpr int REP_G[8] = {1, 1, 1, 1, 1, 1, 1, 1};
struct Args { P p; int ph_lo, ph_hi; };
__global__ void __launch_bounds__(NTHR, 2) mega(const Args a) {
    extern __shared__ __attribute__((aligned(16))) unsigned char lds_raw[];
    LAS unsigned char* lds = (LAS unsigned char*)lds_raw;
    const int wg0 = blockIdx.x, nwg0 = gridDim.x, tid = threadIdx.x;
    for (int u = tid; u < (LDS_BYTES - LDSCTL_OFF) / 4; u += NTHR) ((LAS unsigned*)(lds + LDSCTL_OFF))[u] = 0u;
    __syncthreads();
    if (tid == 0) { const unsigned long long* src = (const unsigned long long*)&a.p;
#pragma unroll
        for (int i = 0; i < 25; ++i) *(LAS unsigned long long*)(lds + LDS_P_OFF + 8 * i) = src[i]; }
    __syncthreads();
    unsigned char* const ws0 = (unsigned char*)lds_ptr(lds, 24);
    XcdBarrier bar = xcd_barrier_post((unsigned*)(ws0 + WS_CTL) + CW_BAR, (volatile LAS unsigned*)(lds + LDSCTL_OFF + 32));
    const int lo = a.ph_lo, hi = a.ph_hi; int ph = 0;
#define PH_BEGIN if (ph >= lo && ph < hi) { unsigned long long wsi_ = (unsigned long long)ws0; int l = l0, wg = wg0, nwg = nwg0; asm volatile("" : "+s"(wsi_), "+s"(l), "+s"(wg), "+s"(nwg) :: "memory"); unsigned char* ws = (unsigned char*)(__attribute__((address_space(1))) unsigned char*)wsi_; const P p = load_P(lds); const int gtid = wg * NTHR + tidx(), gthreads = nwg * NTHR; (void)gtid; (void)gthreads;
#define PH_END } if (ph >= lo && ph + 1 < hi) for (int rb = 0; rb < REP_BAR; ++rb) xcd_barrier(bar); ++ph;
#define PH_END_NOBAR } ++ph;

    int l0 = 0;
    PH_BEGIN (void)l; for (int rep = 0; rep < REP_PRO; ++rep) phase_prologue(p, ws, lds, wg, nwg); PH_END
    PH_BEGIN (void)l;
    { int Kp = PLE; asm volatile("" : "+s"(Kp));
      pg8::Gemm g{(const bf16_t*)(ws + WS_PBF), (const bf16_t*)(ws + WS_WPLE), DEPTH * MP, DEPTH * D, Kp, PLE, PLE}; DiagOrder S{nwg, wg};
      EpiA<FPeD> E{FPeD{(bf16_t*)(ws + WS_PE)}};
      for (int rgp = 0; rgp < REP_G[0]; ++rgp) pg8::gemm_phase<EpiA<FPeD>, DiagOrder, true, true>(lds, g, S, E); }
    for (int l = 0; l < DEPTH; ++l) {
        FPe f{(bf16_t*)(ws + WS_PE) + (size_t)l * MR * D};
        sample_gemm32<0, PLE / 256>((const bf16_t*)(ws + WS_PBF) + (size_t)DEPTH * MP * PLE + (size_t)l * DECB * PLE, PLE, (const bf16_t*)(ws + WS_WPLE) + (size_t)l * D * PLE, PLE, D, f, (float*)nullptr, lds, wg, nwg);
    }
    PH_END_NOBAR
    for (l0 = 0; l0 < DEPTH; ++l0) {
#define HBF_CUR ((bf16_t*)(ws + ((l & 1) ? WS_HBF2 : WS_HBF)))
#define HBF_NXT ((bf16_t*)(ws + ((l & 1) ? WS_HBF : WS_HBF2)))
        PH_BEGIN
        for (int rep = 0; rep < REP_GEMM; ++rep) {
        const bf16_t* A = HBF_CUR; const bf16_t* Wt = (const bf16_t*)(ws + WS_WIN) + (size_t)l * NZ * D;
        pg8::Gemm g{A, Wt, MR, NZ, D, D, D}; pg8::StaticOrder S; S.init(MR, NZ, nwg, wg);
        FIn f{(const float*)(ws + WS_SSQ), (const float*)(ws + WS_LBS) + l * HW, p.bgg + l * GKW, ws, (const LAS float*)(lds + RST_OFF), -1, -1, -1};
        {
            { pg8::Unit u_;
#pragma nounroll
              for (int i = 0; S.next(i, u_); ++i) { if (u_.pm == f.pm0 || u_.pm == f.pm1 || u_.pm == f.pm2) continue; if (f.pm0 < 0) f.pm0 = u_.pm; else if (f.pm1 < 0) f.pm1 = u_.pm; else if (f.pm2 < 0) f.pm2 = u_.pm; } }
            const int t_ = tidx(); LAS float* tb = (LAS float*)(lds + RST_OFF);
            if (t_ < 256) { if (f.pm0 >= 0) tb[t_] = f.rowctx_g(f.pm0 * 256 + t_); if (f.pm1 >= 0) tb[256 + t_] = f.rowctx_g(f.pm1 * 256 + t_); if (f.pm2 >= 0) tb[512 + t_] = f.rowctx_g(f.pm2 * 256 + t_); }
            __syncthreads(); }
        EpiA<FIn> E{f};
        for (int rgp = 0; rgp < REP_G[1]; ++rgp) pg8::gemm_phase<EpiA<FIn>, pg8::StaticOrder, true, true>(lds, g, S, E);
        }
        PH_END
        PH_BEGIN for (int rep = 0; rep < REP_PREP; ++rep) { for (int tkp = wg; tkp < NSH * 32; tkp += nwg) rec_prep_task(ws, lds, tkp); __syncthreads(); } PH_END
        PH_BEGIN for (int rep = 0; rep < REP_REC; ++rep) phase_rec(p, ws, l, lds, wg, nwg); PH_END
        PH_BEGIN
        for (int rep = 0; rep < REP_GEMM; ++rep) {
        { const bf16_t* A = (const bf16_t*)(ws + WS_OG); const bf16_t* Wt = (const bf16_t*)(ws + WS_WUH) + (size_t)l * D * HW;
          pg8::Gemm g{A, Wt, MP, D, HW, D, HW}; pg8::StaticOrder S; S.init(MP, D, nwg, wg);
          EpiAP<FUp1> E{FUp1{(const bf16_t*)(ws + WS_MH), (bf16_t*)(ws + WS_T4)}};
          for (int rgp = 0; rgp < REP_G[2]; ++rgp) pg8::gemm_phase<EpiAP<FUp1>, pg8::StaticOrder, true, true>(lds, g, S, E);
          for (int rgs = 0; rgs < REP_GS; ++rgs) sample_gemm32<0, HW / 256>(A + (size_t)MP * D, D, Wt, HW, D, E.f, (float*)nullptr, lds, wg, nwg); }
        asm volatile("s_waitcnt vmcnt(0)" ::: "memory");
        { const bf16_t* A = (const bf16_t*)(ws + WS_OG) + 1024; const bf16_t* Wt = (const bf16_t*)(ws + WS_WUG) + (size_t)l * D * GVW;
          pg8::Gemm g{A, Wt, MP, D, GVW, D, GVW}; pg8::StaticOrder S; S.init(MP, D, nwg, wg);
          EpiAP<FUp2> E{FUp2{(const bf16_t*)(ws + WS_MG), (const bf16_t*)(ws + WS_T4), (bf16_t*)(ws + WS_MRG)}};
          for (int rgp = 0; rgp < REP_G[3]; ++rgp) pg8::gemm_phase<EpiAP<FUp2>, pg8::StaticOrder, true, true>(lds, g, S, E);
          for (int rgs = 0; rgs < REP_GS; ++rgs) sample_gemm32<0, GVW / 256>(A + (size_t)MP * D, D, Wt, GVW, D, E.f, (float*)nullptr, lds, wg, nwg); }
        }
        PH_END
        PH_BEGIN
        for (int rep = 0; rep < REP_GEMM; ++rep)
        { const bf16_t* A = (const bf16_t*)(ws + WS_MRG); const bf16_t* Wt = (const bf16_t*)(ws + WS_WOUT) + (size_t)l * D * D;
          pg8::Gemm g{A, Wt, MP, D, D, D, D}; pg8::StaticOrder S; S.init(MP, D, nwg, wg);
          EpiPost4 E{HBF_CUR, p.n_post_mix + l * D, (bf16_t*)(ws + WS_T4), (float*)(ws + WS_CTL) + CW_SSQ2, (float*)(ws + WS_CTL) + CW_X4, (unsigned*)(ws + WS_CTL) + CW_X4CNT + l * 32 * 64, (unsigned*)(ws + WS_CTL) + CW_BAR + XB_TMO};
          pg8::gemm_phase<EpiPost4, pg8::StaticOrder, true, true>(lds, g, S, E);
          for (int rgs = 0; rgs < REP_GS; ++rgs) sample_gemm32<0, D / 256>(A + (size_t)MP * D, D, Wt, D, D, FPartS{(float*)(ws + WS_PART4)}, (float*)nullptr, lds, wg, nwg); }
        PH_END
        PH_BEGIN for (int rep = 0; rep < REP_POST; ++rep) thin_post<0>(ws, lds, HBF_CUR, p.n_post_mix + l * D, p.n_pre_ffn + l * D, nullptr, nullptr, wg, nwg); PH_END
        PH_BEGIN
        for (int rep = 0; rep < REP_GEMM; ++rep)
        { const bf16_t* A = (const bf16_t*)(ws + WS_T4); const bf16_t* Wt = (const bf16_t*)(ws + WS_WFF1) + (size_t)l * DFF * D;
          pg8::Gemm g{A, Wt, MP, DFF, D, D, D}; pg8::StaticOrder S; S.init(MP, DFF, nwg, wg);
          FRelu2 f{(bf16_t*)(ws + WS_U), (const float*)(ws + WS_CTL) + CW_SSQ2, (const LAS float*)(lds + RST_OFF), -1, -1, -1, -1};
          { { pg8::Unit u_;
#pragma nounroll
              for (int i = 0; S.next(i, u_); ++i) { if (u_.pm == f.pm0 || u_.pm == f.pm1 || u_.pm == f.pm2 || u_.pm == f.pm3) continue; if (f.pm0 < 0) f.pm0 = u_.pm; else if (f.pm1 < 0) f.pm1 = u_.pm; else if (f.pm2 < 0) f.pm2 = u_.pm; else if (f.pm3 < 0) f.pm3 = u_.pm; } }
            const int t_ = tidx(); LAS float* tb = (LAS float*)(lds + RST_OFF);
            if (t_ < 256) { if (f.pm0 >= 0) tb[t_] = f.rowctx_g(f.pm0 * 256 + t_); if (f.pm1 >= 0) tb[256 + t_] = f.rowctx_g(f.pm1 * 256 + t_); if (f.pm2 >= 0) tb[512 + t_] = f.rowctx_g(f.pm2 * 256 + t_); if (f.pm3 >= 0) tb[768 + t_] = f.rowctx_g(f.pm3 * 256 + t_); }
            __syncthreads(); }
          EpiA<FRelu2> E{f};
          for (int rgp = 0; rgp < REP_G[5]; ++rgp) pg8::gemm_phase<EpiA<FRelu2>, pg8::StaticOrder, true, true>(lds, g, S, E);
          for (int rgs = 0; rgs < REP_GS; ++rgs) sample_gemm64<0, 1>(A + (size_t)MP * D, D, Wt, D, DFF, D, E.f, (float*)nullptr, lds, wg, nwg); }
        PH_END
        PH_BEGIN
        for (int rep = 0; rep < REP_GEMM; ++rep)
        { const bf16_t* A = (const bf16_t*)(ws + WS_U); const bf16_t* Wt = (const bf16_t*)(ws + WS_WFF2) + (size_t)l * D * DFF;
          pg8::Gemm g{A, Wt, MP, D, DFF, DFF, DFF}; pg8::StaticOrder S; S.init(MP, D, nwg, wg);
          EpiPost6 E{(const bf16_t*)(ws + WS_T4), p.n_post_ffn + l * D, (bf16_t*)(ws + WS_HBF3),
                     (float*)(ws + WS_CTL) + CW_X6, (unsigned*)(ws + WS_CTL) + CW_X6CNT + l * 32 * 64, (unsigned*)(ws + WS_CTL) + CW_BAR + XB_TMO};
          pg8::gemm_phase<EpiPost6, pg8::StaticOrder, true, true>(lds, g, S, E);
          for (int rgs = 0; rgs < REP_GS; ++rgs) sample_gemm64<2, 4>(A + (size_t)MP * DFF, DFF, Wt, DFF, D, DFF, FStoreBf{nullptr}, (float*)(ws + WS_PART6), lds, wg, nwg); }
        PH_END
        PH_BEGIN for (int rep = 0; rep < REP_POST; ++rep) thin_post<1>(ws, lds, HBF_CUR, p.n_post_mix + l * D, nullptr, p.n_post_ffn + l * D, (bf16_t*)(ws + WS_HBF3), wg, nwg); PH_END
        PH_BEGIN
        for (int rep = 0; rep < REP_P7; ++rep)
        { const bf16_t* A = (const bf16_t*)(ws + WS_HBF3); const bf16_t* Wt = (const bf16_t*)(ws + WS_WPLG) + (size_t)l * D * D;
          pg8::Gemm g{A, Wt, MP, D, D, D, D}; pg8::StaticOrder S; S.init(MP, D, nwg, wg);
          EpiPle E{FPle{(const bf16_t*)(ws + WS_HBF3), l == DEPTH - 1 ? p.out : (float*)nullptr, HBF_NXT, (const bf16_t*)(ws + WS_PE) + (size_t)l * MR * D}, (float*)(ws + WS_SSQ)};
          pg8::gemm_phase<EpiPle, pg8::StaticOrder, true, true>(lds, g, S, E);
          sample_gemm32<1, D / 256>(A + (size_t)MP * D, D, Wt, D, D, E.f, (float*)(ws + WS_SSQ), lds, wg, nwg); }
        PH_END
    }
#undef PH_BEGIN
#undef PH_END
#undef PH_END_NOBAR
}

#ifndef MK_PER_PHASE
#define MK_PER_PHASE 0
#endif
extern "C" void kernel_launch(void* const* d_in, const int* in_sizes, int n_in, void* d_out, int out_size, void* d_ws, size_t ws_size, hipStream_t stream) {
    static int grid = 0;
    if (grid == 0) {
        if (n_in != 23 || ws_size < WS_END) { fprintf(stderr, "kernel_launch: need 23 inputs and %zu bytes of workspace; got %d inputs, %zu bytes\n", (size_t)WS_END, n_in, ws_size); grid = -1; return; }
        int dev = 0, cus = 0, per_cu = 0;
        if (hipGetDevice(&dev) != hipSuccess || hipDeviceGetAttribute(&cus, hipDeviceAttributeMultiprocessorCount, dev) != hipSuccess) { fprintf(stderr, "kernel_launch: device query failed\n"); grid = -1; return; }
        if (hipFuncSetAttribute((const void*)mega, hipFuncAttributeMaxDynamicSharedMemorySize, LDS_BYTES) != hipSuccess) { fprintf(stderr, "kernel_launch: hipFuncSetAttribute failed\n"); grid = -1; return; }
        if (hipOccupancyMaxActiveBlocksPerMultiprocessor(&per_cu, (const void*)mega, NTHR, LDS_BYTES) != hipSuccess || per_cu < 1) { fprintf(stderr, "kernel_launch: occupancy query reports %d blocks per CU\n", per_cu); (void)hipGetLastError(); per_cu = 1; }
        grid = cus;
    }
    if (grid < 0) return;
    (void)hipMemsetAsync((char*)d_ws + WS_CTL, 0, CTL_BYTES, stream);
    Args a{};
    const float** pf = (const float**)&a.p;
    for (int i = 0; i < 23; ++i) pf[i] = (const float*)d_in[i];
    a.p.out = (float*)d_out; a.p.ws = (unsigned char*)d_ws;
    constexpr int NPH = 2 + DEPTH * 10;
#if MK_PER_PHASE
    for (int k = 0; k < NPH; ++k) { a.ph_lo = k; a.ph_hi = k + 1; hipLaunchKernelGGL(mega, dim3(grid), dim3(NTHR), LDS_BYTES, stream, a); }
#else
    a.ph_lo = 0; a.ph_hi = NPH;
    hipLaunchKernelGGL(mega, dim3(grid), dim3(NTHR), LDS_BYTES, stream, a);
#endif
}
```

```cpp
#include <hip/hip_runtime.h>
#include <cstdio>
#include <cstdint>

__device__ __forceinline__ int tidx() { int t = threadIdx.x; asm volatile("" : "+v"(t)); return t; }

namespace pg8 {
#define PG8_LAS __attribute__((address_space(3)))
typedef unsigned short bf16_t;
typedef short bf16x8 __attribute__((ext_vector_type(8)));
typedef float f32x4 __attribute__((ext_vector_type(4)));
typedef unsigned u32x4 __attribute__((ext_vector_type(4)));
constexpr int BM = 256, BK = 64, HALF = 128, HTB = HALF * BK * 2, STAGE_BYTES = 8 * HTB, NXCD = 8, WGM = 8;

__host__ __device__ __forceinline__ int lds_byte(int r, int c) { const int st = (r >> 4) * 2 + (c >> 5), rr = r & 15, cc = c & 31, ob = rr * 64 + cc * 2; return st * 1024 + (ob ^ (((ob >> 9) & 1) << 5)); }
__host__ __device__ __forceinline__ void stage_rc(int b, int& R, int& C) { const int st = b / 1024, sb = b % 1024, swz = sb ^ (((sb >> 9) & 1) << 5); R = (st >> 1) * 16 + swz / 64; C = (st & 1) * 32 + (swz % 64) / 2; }
__host__ __device__ __forceinline__ int perm32(int rho) { const int n = rho >> 4, i = rho & 15; return 8 * (i >> 2) + 4 * n + (i & 3); }

struct Unit { int pm, pn; };
struct Gemm { const bf16_t* A; const bf16_t* Bt; int M, N, K, lda, ldb; };

struct StaticOrder {
    int nM, nN, nwg, G, c;
    __host__ __device__ __forceinline__ void init(int M, int N, int G_, int c_) { nM = M / BM; nN = N / BM; nwg = nM * nN; G = G_; c = c_; }
    __host__ __device__ __forceinline__ bool next(int i, Unit& u) const {
        const long L = (long)i * G + c; if (L >= nwg) return false;
        int wgid = (int)L; { const int q = nwg / NXCD, r = nwg % NXCD, xcd = wgid % NXCD, off = wgid / NXCD; wgid = (xcd < r ? xcd * (q + 1) : r * (q + 1) + (xcd - r) * q) + off; }
        const int nig = WGM * nN, gid = wgid / nig, fm = gid * WGM, gsz = (nM - fm) < WGM ? (nM - fm) : WGM;
        u.pm = fm + ((wgid % nig) % gsz); u.pn = (wgid % nig) / gsz; return true;
    }
    __device__ __forceinline__ void a_ready(const Unit&) const {}
    __device__ __forceinline__ void done(const Unit&) const {}
};

typedef float f32x2_t __attribute__((ext_vector_type(2)));
typedef __bf16 bf16x2_t __attribute__((ext_vector_type(2)));
__device__ __forceinline__ unsigned cvt_pk_bf16(float lo, float hi) { return __builtin_bit_cast(unsigned, __builtin_convertvector((f32x2_t){lo, hi}, bf16x2_t)); }

template <class Epi, class Sched, bool ALIGN_EPI = false, bool SP2 = false>
__device__ __forceinline__ void gemm_phase(PG8_LAS unsigned char* lds, const Gemm g, const Sched& S, const Epi& E) {
    const int tid = tidx();
    const int wid = __builtin_amdgcn_readfirstlane(tid >> 6), lane = tid & 63, wr = wid >> 2, wc = wid & 3, fr = lane & 15, fq = lane >> 4;
    const int K = g.K, nt = K / BK;
    unsigned voffA[2], voffB[2];
#pragma unroll
    for (int i = 0; i < 2; ++i) { int R, C; stage_rc(tid * 16 + i * 8192, R, C); const int Rb = Epi::PERM ? ((R & ~31) + perm32(R & 31)) : R;
        voffA[i] = (unsigned)(R * g.lda + C) * 2u; voffB[i] = (unsigned)(Rb * g.ldb + C) * 2u; }
    const size_t kstep = (size_t)(BK * 2);
    const size_t hstepA = (size_t)HALF * g.lda * 2, hstepB = (size_t)HALF * g.ldb * 2;
    const size_t tstepA = 2 * hstepA, tstepB = 2 * hstepB;
    const unsigned ldsw = (unsigned)wid * 1024u;
    const int aoff = lds_byte(wr * 64 + fr, fq * 8), boff = lds_byte(wc * 32 + fr, fq * 8);
#define PG8_SA(b, h) (((b) * 2 + (h)) * HTB)
#define PG8_SB(b, h) ((4 + (b) * 2 + (h)) * HTB)
#define PG8_STAGE(bufoff, gbase, voff) do { _Pragma("unroll") for (int _i = 0; _i < 2; ++_i) \
        __builtin_amdgcn_global_load_lds((const unsigned*)((const char*)(gbase) + (voff)[_i]), (PG8_LAS unsigned*)(lds + (bufoff) + ldsw + _i * 8192), 16, 0, 0); } while (0)
#define PG8_LDA(dst, b, h) do { _Pragma("unroll") for (int m = 0; m < 4; ++m) _Pragma("unroll") for (int k = 0; k < 2; ++k) dst[m][k] = *(const PG8_LAS bf16x8*)(lds + PG8_SA(b, h) + aoff + m * 2048 + k * 1024); } while (0)
#define PG8_LDB(dst, b, h) do { _Pragma("unroll") for (int n = 0; n < 2; ++n) _Pragma("unroll") for (int k = 0; k < 2; ++k) dst[n][k] = *(const PG8_LAS bf16x8*)(lds + PG8_SB(b, h) + boff + n * 2048 + k * 1024); } while (0)
#define PG8_MMA(ai, bj, At, Bt) do { __builtin_amdgcn_s_setprio(1); _Pragma("unroll") for (int m = 0; m < 4; ++m) _Pragma("unroll") for (int n = 0; n < 2; ++n) _Pragma("unroll") for (int k = 0; k < 2; ++k) \
        acc[ai][bj][m][n] = __builtin_amdgcn_mfma_f32_16x16x32_bf16(Bt[n][k], At[m][k], acc[ai][bj][m][n], 0, 0, 0); __builtin_amdgcn_s_setprio(0); } while (0)
#define PG8_WAIT_V(n) asm volatile("s_waitcnt vmcnt(" #n ")" ::: "memory")
#define PG8_WAIT_L(n) asm volatile("s_waitcnt lgkmcnt(" #n ")" ::: "memory")
#define PG8_BAR __builtin_amdgcn_s_barrier()
#define PG8_SCHED __builtin_amdgcn_sched_barrier(0)
    Unit cur, nxt; int ui = 0;
    if (!S.next(0, cur)) return;
    f32x4 acc[2][2][4][2];
#pragma unroll
    for (int a = 0; a < 2; ++a)
#pragma unroll
        for (int b = 0; b < 2; ++b)
#pragma unroll
            for (int m = 0; m < 4; ++m)
#pragma unroll
                for (int n = 0; n < 2; ++n) acc[a][b][m][n] = (f32x4){0.f, 0.f, 0.f, 0.f};
    bf16x8 At[4][2], B0[2][2], B1[2][2];
    const char* cA = (const char*)g.A + (size_t)cur.pm * tstepA; const char* cB = (const char*)g.Bt + (size_t)cur.pn * tstepB;
    S.a_ready(cur);
    if constexpr (SP2) {
        PG8_STAGE(PG8_SB(0, 0), cB, voffB); PG8_STAGE(PG8_SB(0, 1), cB + hstepB, voffB); PG8_STAGE(PG8_SA(0, 0), cA, voffA); PG8_STAGE(PG8_SA(0, 1), cA + hstepA, voffA);
        if (wr == 1) PG8_BAR;
        PG8_WAIT_V(2); PG8_BAR;
        PG8_STAGE(PG8_SB(1, 0), cB + kstep, voffB); PG8_STAGE(PG8_SA(1, 0), cA + kstep, voffA); PG8_STAGE(PG8_SB(1, 1), cB + hstepB + kstep, voffB);
        PG8_WAIT_V(6); PG8_BAR;
    } else {
        PG8_STAGE(PG8_SB(0, 0), cB, voffB); PG8_STAGE(PG8_SA(0, 0), cA, voffA); PG8_STAGE(PG8_SB(0, 1), cB + hstepB, voffB); PG8_STAGE(PG8_SA(0, 1), cA + hstepA, voffA);
        if (wr == 1) PG8_BAR;
        PG8_WAIT_V(4); PG8_BAR;
        PG8_STAGE(PG8_SB(1, 0), cB + kstep, voffB); PG8_STAGE(PG8_SA(1, 0), cA + kstep, voffA); PG8_STAGE(PG8_SB(1, 1), cB + hstepB + kstep, voffB);
        PG8_WAIT_V(6); PG8_BAR;
    }
    for (;;) {
        const bool has_next = S.next(ui + 1, nxt);
        const char* nA = has_next ? (const char*)g.A + (size_t)nxt.pm * tstepA : cA; const char* nB = has_next ? (const char*)g.Bt + (size_t)nxt.pn * tstepB : cB;
        for (int t = 0; t < nt; t += 2) {
            const bool last = (t == nt - 2);
            const char* a1 = cA + (size_t)(t + 1) * kstep;
            const char* a2 = last ? nA : cA + (size_t)(t + 2) * kstep; const char* b2 = last ? nB : cB + (size_t)(t + 2) * kstep;
            const char* a3 = a2 + kstep; const char* b3 = b2 + kstep;
            if (last && has_next) S.a_ready(nxt);
            if constexpr (SP2) {
            PG8_LDB(B0, 0, 0); PG8_LDB(B1, 0, 1); PG8_SCHED; PG8_LDA(At, 0, 0); PG8_STAGE(PG8_SA(1, 1), a1 + hstepA, voffA);
            PG8_WAIT_V(8); PG8_WAIT_L(0); PG8_BAR; PG8_MMA(0, 0, At, B0); PG8_MMA(0, 1, At, B1); PG8_BAR; PG8_SCHED;
            PG8_LDA(At, 0, 1); PG8_STAGE(PG8_SB(0, 0), b2, voffB); PG8_STAGE(PG8_SB(0, 1), b2 + hstepB, voffB); PG8_STAGE(PG8_SA(0, 0), a2, voffA);
            PG8_WAIT_V(8); PG8_WAIT_L(0); PG8_BAR; PG8_MMA(1, 0, At, B0); PG8_MMA(1, 1, At, B1); PG8_BAR; PG8_SCHED;
            PG8_LDB(B0, 1, 0); PG8_LDB(B1, 1, 1); PG8_SCHED; PG8_LDA(At, 1, 0); PG8_STAGE(PG8_SA(0, 1), a2 + hstepA, voffA);
            PG8_WAIT_V(8); PG8_WAIT_L(0); PG8_BAR; PG8_MMA(0, 0, At, B0); PG8_MMA(0, 1, At, B1); PG8_BAR; PG8_SCHED;
            PG8_LDA(At, 1, 1); PG8_STAGE(PG8_SB(1, 0), b3, voffB); PG8_STAGE(PG8_SB(1, 1), b3 + hstepB, voffB); PG8_STAGE(PG8_SA(1, 0), a3, voffA);
            PG8_WAIT_V(8); PG8_WAIT_L(0); PG8_BAR; PG8_MMA(1, 0, At, B0); PG8_MMA(1, 1, At, B1); PG8_BAR; PG8_SCHED;
            } else {
            PG8_LDB(B0, 0, 0); PG8_SCHED; PG8_LDA(At, 0, 0); PG8_STAGE(PG8_SA(1, 1), a1 + hstepA, voffA);
            PG8_WAIT_L(8); PG8_BAR; PG8_WAIT_L(0); PG8_MMA(0, 0, At, B0); PG8_BAR; PG8_SCHED;
            PG8_LDB(B1, 0, 1); PG8_STAGE(PG8_SB(0, 0), b2, voffB);
            PG8_BAR; PG8_WAIT_L(0); PG8_MMA(0, 1, At, B1); PG8_BAR;
            PG8_LDA(At, 0, 1); PG8_STAGE(PG8_SA(0, 0), a2, voffA);
            PG8_BAR; PG8_WAIT_L(0); PG8_MMA(1, 0, At, B0); PG8_BAR; PG8_SCHED;
            PG8_STAGE(PG8_SB(0, 1), b2 + hstepB, voffB);
            PG8_WAIT_V(6); PG8_BAR; PG8_MMA(1, 1, At, B1); PG8_BAR;
            PG8_LDB(B0, 1, 0); PG8_SCHED; PG8_LDA(At, 1, 0); PG8_STAGE(PG8_SA(0, 1), a2 + hstepA, voffA);
            PG8_WAIT_L(8); PG8_BAR; PG8_WAIT_L(0); PG8_MMA(0, 0, At, B0); PG8_BAR; PG8_SCHED;
            PG8_LDB(B1, 1, 1); PG8_STAGE(PG8_SB(1, 0), b3, voffB);
            PG8_BAR; PG8_WAIT_L(0); PG8_MMA(0, 1, At, B1); PG8_BAR;
            PG8_LDA(At, 1, 1); PG8_STAGE(PG8_SA(1, 0), a3, voffA);
            PG8_BAR; PG8_WAIT_L(0); PG8_MMA(1, 0, At, B0); PG8_BAR; PG8_SCHED;
            PG8_STAGE(PG8_SB(1, 1), b3 + hstepB, voffB);
            PG8_WAIT_V(6); PG8_BAR; PG8_MMA(1, 1, At, B1); PG8_BAR;
            }
        }
        if constexpr (ALIGN_EPI) { if (wr == 0) PG8_BAR; }
        if constexpr (!Epi::AFTER_DRAIN) { E(acc, cur, wr, wc, fr, fq); S.done(cur); }
        if (!has_next) break;
#pragma unroll
        for (int a = 0; a < 2; ++a)
#pragma unroll
            for (int b = 0; b < 2; ++b)
#pragma unroll
                for (int m = 0; m < 4; ++m)
#pragma unroll
                    for (int n = 0; n < 2; ++n) acc[a][b][m][n] = (f32x4){0.f, 0.f, 0.f, 0.f};
        cur = nxt; cA = nA; cB = nB; ++ui;
        if constexpr (ALIGN_EPI) { if (wr == 1) PG8_BAR; }
    }
    PG8_WAIT_V(0);
    if constexpr (!ALIGN_EPI) { if (wr == 0) PG8_BAR; }
    PG8_BAR;
    if constexpr (Epi::AFTER_DRAIN) { E.fused(acc, cur, wr, wc, fr, fq, lds, wid, lane); S.done(cur); }
#undef PG8_SA
#undef PG8_SB
#undef PG8_STAGE
#undef PG8_LDA
#undef PG8_LDB
#undef PG8_MMA
#undef PG8_WAIT_V
#undef PG8_WAIT_L
#undef PG8_BAR
#undef PG8_SCHED
}
}

#define LAS __attribute__((address_space(3)))
typedef unsigned short bf16_t;
typedef float f32x4 __attribute__((ext_vector_type(4)));
typedef unsigned u32x4 __attribute__((ext_vector_type(4)));
typedef unsigned u32x2 __attribute__((ext_vector_type(2)));

constexpr int NWAVES = 8, NTHR = 512;
constexpr int D = 2048, BATCH = 4, SEQ = 2048, DEPTH = 4, DECB = 128;
constexpr int MP = BATCH * SEQ;
constexpr int MT = MP + DECB;
constexpr int MR = 8448;
constexpr int HH = 8, HK = 128, HV = 128, HW = 1024;
constexpr int GH = 4, GK = 128, GV = 256, GKW = 512, GVW = 1024, GR = 16;
constexpr int DFF = 8192, PLE = 256;
constexpr int NIN = 11280;
constexpr int NZ = 11776;
constexpr int C_GLR = 7168;
constexpr float EPS = 1e-6f;
constexpr int SSQW = 64;

constexpr size_t al256(size_t x) { return (x + 255) & ~(size_t)255; }
constexpr size_t WS_CTL = 0, CTL_BYTES = 1u << 20;
constexpr int CW_X6CNT = 8192, CW_X4CNT = 16384, CW_X6 = 32768, CW_X4 = 98304, CW_SSQ2 = 163840;
static_assert(CW_X6CNT + DEPTH * 32 * 64 <= CW_X4CNT && CW_X4CNT + DEPTH * 32 * 64 <= CW_X6 && CW_X6 + MP * 8 <= CW_X4 && CW_X4 + MP * 8 <= CW_SSQ2 && (size_t)(CW_SSQ2 + MR * 8) * 4 <= CTL_BYTES, "CTL sub-regions");
constexpr size_t WS_LBS = WS_CTL + CTL_BYTES;
constexpr size_t WS_SSQ = WS_LBS + al256(4 * 1024 * 4);
constexpr size_t WS_WIN = WS_SSQ + al256((size_t)MR * SSQW * 4);
constexpr size_t WS_WUH = WS_WIN + (size_t)DEPTH * NZ * D * 2;
constexpr size_t WS_WUG = WS_WUH + (size_t)DEPTH * D * HW * 2;
constexpr size_t WS_WOUT = WS_WUG + (size_t)DEPTH * D * GVW * 2;
constexpr size_t WS_WFF1 = WS_WOUT + (size_t)DEPTH * D * D * 2;
constexpr size_t WS_WFF2 = WS_WFF1 + (size_t)DEPTH * DFF * D * 2;
constexpr size_t WS_WPLE = WS_WFF2 + (size_t)DEPTH * D * DFF * 2;
constexpr size_t WS_WPLG = WS_WPLE + (size_t)DEPTH * D * PLE * 2;
constexpr size_t WS_H32 = WS_WPLG + (size_t)DEPTH * D * D * 2;
constexpr size_t WS_HBF3 = WS_H32;
constexpr size_t WS_HBF = WS_H32 + (size_t)MR * D * 4;
constexpr size_t WS_QH = WS_HBF + (size_t)MR * D * 2;
constexpr size_t WS_KH = WS_QH + (size_t)MR * HW * 2;
constexpr size_t WS_VH = WS_KH + (size_t)MR * HW * 2;
constexpr size_t WS_GHG = WS_VH + (size_t)MR * HW * 2;
constexpr size_t WS_LOGF = WS_GHG + (size_t)MR * HW * 2;
constexpr size_t WS_QG = WS_LOGF + (size_t)MR * HW * 4;
constexpr size_t WS_KG = WS_QG + (size_t)MR * GKW * 2;
constexpr size_t WS_VG = WS_KG + (size_t)MR * GKW * 2;
constexpr size_t WS_RG = WS_VG + (size_t)MR * GVW * 2;
constexpr size_t WS_LOGA = WS_RG + (size_t)MR * GVW * 2;
constexpr size_t WS_MH = WS_LOGA + (size_t)MR * GKW * 4;
constexpr size_t WS_MG = WS_MH + (size_t)MR * D * 2;
constexpr size_t WS_T32 = WS_MG + (size_t)MR * D * 2;
constexpr size_t WS_OG = WS_T32 + (size_t)MR * D * 4;
constexpr size_t WS_MRG = WS_OG + (size_t)MR * D * 2;
constexpr size_t WS_U = WS_MRG + (size_t)MR * D * 2;
constexpr size_t WS_PE = WS_U + (size_t)MR * DFF * 2;
constexpr size_t WS_HBF2 = WS_PE + (size_t)DEPTH * MR * D * 2;
constexpr size_t WS_PBF = WS_HBF2 + (size_t)MR * D * 2;
constexpr size_t WS_PART = WS_PBF + (size_t)DEPTH * MT * PLE * 2;
constexpr size_t WS_H32B = WS_PART + (size_t)12 * DECB * D * 4;
constexpr size_t WS_H32C = WS_H32B + (size_t)MR * D * 4;
constexpr size_t WS_END = WS_H32C + (size_t)MR * D * 4;

constexpr int LDS_BYTES = 147456;

struct P {
    const float *xp, *xs, *pp, *ps, *sth, *stg, *n_pre_mix, *n_post_mix, *n_pre_ffn, *n_post_ffn, *w_in, *lbp, *hgn, *w_hup, *wgg, *bgg, *gln, *w_gup, *w_out, *w_ff1, *w_ff2, *w_ple, *w_plg;
    float* out; unsigned char* ws;
};

__device__ __forceinline__ float bf2f(bf16_t b) { return __uint_as_float(((unsigned)b) << 16); }
__device__ __forceinline__ unsigned pk2(float lo, float hi) { return pg8::cvt_pk_bf16(lo, hi); }
__device__ __forceinline__ void unpack8(const u32x4 w, float (&v)[8]) {
    v[0] = __uint_as_float(w.x << 16); v[1] = __uint_as_float(w.x & 0xffff0000u); v[2] = __uint_as_float(w.y << 16); v[3] = __uint_as_float(w.y & 0xffff0000u);
    v[4] = __uint_as_float(w.z << 16); v[5] = __uint_as_float(w.z & 0xffff0000u); v[6] = __uint_as_float(w.w << 16); v[7] = __uint_as_float(w.w & 0xffff0000u);
}
__device__ __forceinline__ u32x4 pack8(const float (&v)[8]) { u32x4 w; w.x = pk2(v[0], v[1]); w.y = pk2(v[2], v[3]); w.z = pk2(v[4], v[5]); w.w = pk2(v[6], v[7]); return w; }
__device__ __forceinline__ float clampf(float x, float lo, float hi) { return __builtin_amdgcn_fmed3f(x, lo, hi); }
__device__ __forceinline__ float sigm(float x) { return __builtin_amdgcn_rcpf(1.f + __builtin_amdgcn_exp2f(x * -1.4426950408889634f)); }
__device__ __forceinline__ float silu(float x) { return x * sigm(x); }
__device__ __forceinline__ float wave_sum(float v) {
#pragma unroll
    for (int o = 1; o < 64; o <<= 1) v += __shfl_xor(v, o);
    return v;
}

struct FIn {
    const float* ssq; const float* lbs; const float* bgg; unsigned char* wsb;
    const LAS float* rst; int pm0, pm1, pm2;
    __device__ __forceinline__ float rowctx(int row) const {
        const int pm = row >> 8, rl = row & 255;
        if (pm == pm0) return rst[rl];
        if (pm == pm1) return rst[256 + rl];
        if (pm == pm2) return rst[512 + rl];
        float sc = 0.f; const int np = row >= MP ? SSQW : 8;
#pragma nounroll
        for (int i = 0; i < np; ++i) sc += ssq[(size_t)row * SSQW + i];
        return rsqrtf(sc * (1.f / D) + EPS);
    }
    __device__ __forceinline__ float rowctx_g(int row) const {
        const f32x4* p = (const f32x4*)(ssq + (size_t)row * SSQW); float s = 0.f;
        { const f32x4 x = p[0], y = p[1]; s = ((x[0] + x[1]) + (x[2] + x[3])) + ((y[0] + y[1]) + (y[2] + y[3])); }
        if (row >= MP) {
#pragma unroll
            for (int i = 2; i < SSQW / 4; ++i) { const f32x4 x = p[i]; s += (x[0] + x[1]) + (x[2] + x[3]); } }
        return rsqrtf(s * (1.f / D) + EPS);
    }
    __device__ __forceinline__ void apply8(int row, int col, const float (&a)[8], float rs) const {
        float v[8];
#pragma unroll
        for (int j = 0; j < 8; ++j) v[j] = a[j] * rs;
        const float rsn = rs * -1.4426950408889634f;
        if (col < 1024) {
#pragma unroll
            for (int j = 0; j < 8; ++j) v[j] = v[j] * __builtin_amdgcn_rcpf(1.f + __builtin_amdgcn_exp2f(a[j] * rsn));
            *(u32x4*)((bf16_t*)(wsb + WS_QH) + (size_t)row * HW + col) = pack8(v);
        } else if (col < 2048) {
            const int c = col - 1024; float lg[8], kk[8];
            const f32x4 l0 = *(const f32x4*)(lbs + c), l1 = *(const f32x4*)(lbs + c + 4);
#pragma unroll
            for (int j = 0; j < 8; ++j) { const float lb = j < 4 ? l0[j] : l1[j - 4]; const float e = __expf(-clampf(v[j], -30.f, 30.f)); const float sg = __builtin_amdgcn_rcpf(1.f + e);
                lg[j] = __builtin_amdgcn_logf(lb + (1.f - lb) * sg) * 0.6931471805599453f; kk[j] = (1.f - lb) * e * sg; }
            *(f32x4*)((float*)(wsb + WS_LOGF) + (size_t)row * HW + c) = (f32x4){lg[0], lg[1], lg[2], lg[3]}; *(f32x4*)((float*)(wsb + WS_LOGF) + (size_t)row * HW + c + 4) = (f32x4){lg[4], lg[5], lg[6], lg[7]};
            *(u32x4*)((bf16_t*)(wsb + WS_KH) + (size_t)row * HW + c) = pack8(kk);
        } else if (col < 3072) {
            *(u32x4*)((bf16_t*)(wsb + WS_VH) + (size_t)row * HW + (col - 2048)) = pack8(v);
        } else if (col < 4096) {
#pragma unroll
            for (int j = 0; j < 8; ++j) v[j] = v[j] * __builtin_amdgcn_rcpf(1.f + __builtin_amdgcn_exp2f(a[j] * rsn));
            *(u32x4*)((bf16_t*)(wsb + WS_GHG) + (size_t)row * HW + (col - 3072)) = pack8(v);
        } else if (col < 4608) {
            *(u32x4*)((bf16_t*)(wsb + WS_QG) + (size_t)row * GKW + (col - 4096)) = pack8(v);
        } else if (col < 5120) {
            *(u32x4*)((bf16_t*)(wsb + WS_KG) + (size_t)row * GKW + (col - 4608)) = pack8(v);
        } else if (col < 6144) {
            *(u32x4*)((bf16_t*)(wsb + WS_VG) + (size_t)row * GVW + (col - 5120)) = pack8(v);
        } else if (col < 7168) {
#pragma unroll
            for (int j = 0; j < 8; ++j) v[j] = v[j] * __builtin_amdgcn_rcpf(1.f + __builtin_amdgcn_exp2f(a[j] * rsn));
            *(u32x4*)((bf16_t*)(wsb + WS_RG) + (size_t)row * GVW + (col - 6144)) = pack8(v);
        } else if (col < 7680) {
            const int c = col - 7168; float lg[8];
            const f32x4 b0 = *(const f32x4*)(bgg + c), b1 = *(const f32x4*)(bgg + c + 4);
#pragma unroll
            for (int j = 0; j < 8; ++j) { const float x = v[j] + (j < 4 ? b0[j] : b1[j - 4]); lg[j] = (fminf(x, 0.f) - __builtin_amdgcn_logf(1.f + __expf(-fabsf(x))) * 0.6931471805599453f) * (1.f / 16.f); }
            *(f32x4*)((float*)(wsb + WS_LOGA) + (size_t)row * GKW + c) = (f32x4){lg[0], lg[1], lg[2], lg[3]}; *(f32x4*)((float*)(wsb + WS_LOGA) + (size_t)row * GKW + c + 4) = (f32x4){lg[4], lg[5], lg[6], lg[7]};
        } else if (col < 9728) {
#pragma unroll
            for (int j = 0; j < 8; ++j) v[j] = __builtin_amdgcn_rcpf(1.f + __builtin_amdgcn_exp2f(a[j] * rsn));
            *(u32x4*)((bf16_t*)(wsb + WS_MH) + (size_t)row * D + (col - 7680)) = pack8(v);
        } else {
#pragma unroll
            for (int j = 0; j < 8; ++j) v[j] = __builtin_amdgcn_rcpf(1.f + __builtin_amdgcn_exp2f(a[j] * rsn));
            *(u32x4*)((bf16_t*)(wsb + WS_MG) + (size_t)row * D + (col - 9728)) = pack8(v);
        }
    }
};
#ifndef PD1
#define PD1 4
#endif
#ifndef PD2
#define PD2 4
#endif
#ifndef PD3
#define PD3 4
#endif
#ifndef PD6
#define PD6 4
#endif
struct FUp1 {
    const bf16_t* mh; bf16_t* T;
    __device__ __forceinline__ float rowctx(int) const { return 0.f; }
    __device__ __forceinline__ void apply8(int row, int col, const float (&a)[8], float) const {
        float g[8], v[8]; unpack8(*(const u32x4*)(mh + (size_t)row * D + col), g);
#pragma unroll
        for (int j = 0; j < 8; ++j) v[j] = a[j] * g[j];
        *(u32x4*)(T + (size_t)row * D + col) = pack8(v);
    }
    struct Pre { u32x4 g; }; static constexpr int PDIST = PD1;
    __device__ __forceinline__ Pre preload(int row, int col) const { return Pre{*(const u32x4*)(mh + (size_t)row * D + col)}; }
    __device__ __forceinline__ void apply8p(int row, int col, const float (&a)[8], const Pre& p) const {
        float g[8], v[8]; unpack8(p.g, g);
#pragma unroll
        for (int j = 0; j < 8; ++j) v[j] = a[j] * g[j];
        *(u32x4*)(T + (size_t)row * D + col) = pack8(v);
    }
};
struct FUp2 {
    const bf16_t* mg; const bf16_t* T; bf16_t* out;
    __device__ __forceinline__ float rowctx(int) const { return 0.f; }
    __device__ __forceinline__ void apply8(int row, int col, const float (&a)[8], float) const {
        float g[8], v[8]; unpack8(*(const u32x4*)(mg + (size_t)row * D + col), g);
        float t[8]; unpack8(*(const u32x4*)(T + (size_t)row * D + col), t);
#pragma unroll
        for (int j = 0; j < 8; ++j) v[j] = t[j] + a[j] * g[j];
        *(u32x4*)(out + (size_t)row * D + col) = pack8(v);
    }
    struct Pre { u32x4 g, t; }; static constexpr int PDIST = PD2;
    __device__ __forceinline__ Pre preload(int row, int col) const { return Pre{*(const u32x4*)(mg + (size_t)row * D + col), *(const u32x4*)(T + (size_t)row * D + col)}; }
    __device__ __forceinline__ void apply8p(int row, int col, const float (&a)[8], const Pre& p) const {
        float g[8], t[8], v[8]; unpack8(p.g, g); unpack8(p.t, t);
#pragma unroll
        for (int j = 0; j < 8; ++j) v[j] = t[j] + a[j] * g[j];
        *(u32x4*)(out + (size_t)row * D + col) = pack8(v);
    }
};
struct FPartS {
    float* dst;
    __device__ __forceinline__ float rowctx(int) const { return 0.f; }
    __device__ __forceinline__ void apply8(int row, int col, const float (&a)[8], float) const {
        float* q = dst + (size_t)(row - MP) * D + col; *(f32x4*)q = (f32x4){a[0], a[1], a[2], a[3]}; *(f32x4*)(q + 4) = (f32x4){a[4], a[5], a[6], a[7]}; }
};
struct FStoreBf {
    bf16_t* T;
    __device__ __forceinline__ float rowctx(int) const { return 0.f; }
    __device__ __forceinline__ void apply8(int row, int col, const float (&a)[8], float) const { float v[8];
#pragma unroll
        for (int j = 0; j < 8; ++j) v[j] = a[j];
        *(u32x4*)(T + (size_t)row * D + col) = pack8(v); }
};
struct FStore32 {
    float* T; int ld;
    __device__ __forceinline__ float rowctx(int) const { return 0.f; }
    __device__ __forceinline__ void apply8(int row, int col, const float (&a)[8], float) const {
        *(f32x4*)(T + (size_t)row * ld + col) = (f32x4){a[0], a[1], a[2], a[3]}; *(f32x4*)(T + (size_t)row * ld + col + 4) = (f32x4){a[4], a[5], a[6], a[7]};
    }
};
struct FRelu2 {
    bf16_t* U; const float* ssq2; const LAS float* rst; int pm0, pm1, pm2, pm3;
    __device__ __forceinline__ float rowctx_g(int row) const {
        const f32x4* p = (const f32x4*)(ssq2 + (size_t)row * 8); const f32x4 x = p[0], y = p[1];
        return rsqrtf((((x[0] + x[1]) + (x[2] + x[3])) + ((y[0] + y[1]) + (y[2] + y[3]))) * (1.f / D) + EPS); }
    __device__ __forceinline__ float rowctx(int row) const {
        const int pm = row >> 8, rl = row & 255;
        if (pm == pm0) return rst[rl];
        if (pm == pm1) return rst[256 + rl];
        if (pm == pm2) return rst[512 + rl];
        if (pm == pm3) return rst[768 + rl];
        return rowctx_g(row); }
    __device__ __forceinline__ void apply8(int row, int col, const float (&a)[8], float rs) const {
        float v[8];
#pragma unroll
        for (int j = 0; j < 8; ++j) { const float r = fmaxf(a[j], 0.f) * rs; v[j] = r * r; }
        *(u32x4*)(U + (size_t)row * DFF + col) = pack8(v);
    }
};
struct FPe {
    bf16_t* O;
    __device__ __forceinline__ float rowctx(int) const { return 0.f; }
    __device__ __forceinline__ void apply8(int row, int col, const float (&a)[8], float) const { float v[8];
#pragma unroll
        for (int j = 0; j < 8; ++j) v[j] = a[j];
        *(u32x4*)(O + (size_t)row * D + col) = pack8(v); }
};
struct FPeD {
    bf16_t* pe;
    __device__ __forceinline__ float rowctx(int) const { return 0.f; }
    __device__ __forceinline__ void apply8(int row, int col, const float (&a)[8], float) const { float v[8]; const int ll = col >> 11;
#pragma unroll
        for (int j = 0; j < 8; ++j) v[j] = a[j];
        *(u32x4*)(pe + ((size_t)ll * MR + (row - ll * MP)) * D + (col & (D - 1))) = pack8(v); }
};
struct DiagOrder {
    int G, c;
    __device__ __forceinline__ bool next(int i, pg8::Unit& u) const { const int L = i * G + c; if (L >= DEPTH * 256) return false; const int ll = L >> 8, r = L & 255; u.pm = ll * 32 + (r >> 3); u.pn = ll * 8 + (r & 7); return true; }
    __device__ __forceinline__ void a_ready(const pg8::Unit&) const {}
    __device__ __forceinline__ void done(const pg8::Unit&) const {}
};
struct FPle {
    const bf16_t* h2; float* out32; bf16_t* hbf; const bf16_t* pe;
    __device__ __forceinline__ float apply8s(int row, int col, const float (&a)[8]) const {
        float e[8], v[8]; unpack8(*(const u32x4*)(pe + (size_t)row * D + col), e);
        float hh[8]; unpack8(*(const u32x4*)(h2 + (size_t)row * D + col), hh); float s = 0.f;
#pragma unroll
        for (int j = 0; j < 8; ++j) { v[j] = hh[j] + sigm(a[j]) * e[j]; s += v[j] * v[j]; }
        if (out32) { *(f32x4*)(out32 + (size_t)row * D + col) = (f32x4){v[0], v[1], v[2], v[3]}; *(f32x4*)(out32 + (size_t)row * D + col + 4) = (f32x4){v[4], v[5], v[6], v[7]}; }
        *(u32x4*)(hbf + (size_t)row * D + col) = pack8(v);
        return s;
    }
    struct Pre { u32x4 e, hh; }; static constexpr int PDIST = PD3;
    __device__ __forceinline__ Pre preload(int row, int col) const { return Pre{*(const u32x4*)(pe + (size_t)row * D + col), *(const u32x4*)(h2 + (size_t)row * D + col)}; }
    __device__ __forceinline__ float apply8sp(int row, int col, const float (&a)[8], const Pre& p) const {
        float e[8], hh[8], v[8]; unpack8(p.e, e); unpack8(p.hh, hh); float s = 0.f;
#pragma unroll
        for (int j = 0; j < 8; ++j) { v[j] = hh[j] + sigm(a[j]) * e[j]; s += v[j] * v[j]; }
        if (out32) { *(f32x4*)(out32 + (size_t)row * D + col) = (f32x4){v[0], v[1], v[2], v[3]}; *(f32x4*)(out32 + (size_t)row * D + col + 4) = (f32x4){v[4], v[5], v[6], v[7]}; }
        *(u32x4*)(hbf + (size_t)row * D + col) = pack8(v);
        return s;
    }
};

template <class F> struct EpiA {
    static constexpr bool PERM = true, AFTER_DRAIN = false; F f;
    __device__ __forceinline__ void operator()(const f32x4 (&acc)[2][2][4][2], const pg8::Unit& u, int wr, int wc, int fr, int fq) const {
#pragma unroll
        for (int ai = 0; ai < 2; ++ai)
#pragma unroll
            for (int m = 0; m < 4; ++m) { const int row = u.pm * 256 + ai * 128 + wr * 64 + m * 16 + fr; const float ctx = f.rowctx(row);
#pragma unroll
                for (int bj = 0; bj < 2; ++bj) { const int col = u.pn * 256 + bj * 128 + wc * 32 + 8 * fq;
                    const float v[8] = {acc[ai][bj][m][0][0], acc[ai][bj][m][0][1], acc[ai][bj][m][0][2], acc[ai][bj][m][0][3], acc[ai][bj][m][1][0], acc[ai][bj][m][1][1], acc[ai][bj][m][1][2], acc[ai][bj][m][1][3]};
                    f.apply8(row, col, v, ctx); } }
    }
};
template <class F> struct EpiAP {
    static constexpr bool PERM = true, AFTER_DRAIN = false; F f;
    __device__ __forceinline__ void operator()(const f32x4 (&acc)[2][2][4][2], const pg8::Unit& u, int wr, int wc, int fr, int fq) const {
        typename F::Pre pre[16];
        const int row0 = u.pm * 256 + wr * 64 + fr, col0 = u.pn * 256 + wc * 32 + 8 * fq;
#define EPG_ROW(g) (row0 + ((g) >> 3) * 128 + (((g) >> 1) & 3) * 16)
#define EPG_COL(g) (col0 + ((g) & 1) * 128)
#pragma unroll
        for (int g = 0; g < F::PDIST; ++g) pre[g] = f.preload(EPG_ROW(g), EPG_COL(g));
        __builtin_amdgcn_sched_barrier(0);
#pragma unroll
        for (int g = 0; g < 16; ++g) { const int ai = g >> 3, m = (g >> 1) & 3, bj = g & 1;
            if (g + F::PDIST < 16) { pre[(g + F::PDIST) & 15] = f.preload(EPG_ROW(g + F::PDIST), EPG_COL(g + F::PDIST)); __builtin_amdgcn_sched_barrier(0); }
            const float v[8] = {acc[ai][bj][m][0][0], acc[ai][bj][m][0][1], acc[ai][bj][m][0][2], acc[ai][bj][m][0][3], acc[ai][bj][m][1][0], acc[ai][bj][m][1][1], acc[ai][bj][m][1][2], acc[ai][bj][m][1][3]};
            f.apply8p(EPG_ROW(g), EPG_COL(g), v, pre[g]);
            __builtin_amdgcn_sched_barrier(0); }
    }
};
struct EpiPle {
    static constexpr bool PERM = true, AFTER_DRAIN = true; FPle f; float* ssq;
    __device__ __forceinline__ void operator()(const f32x4 (&)[2][2][4][2], const pg8::Unit&, int, int, int, int) const {}
    __device__ __forceinline__ void fused(f32x4 (&acc)[2][2][4][2], const pg8::Unit& u, int wr, int wc, int fr, int fq, LAS unsigned char* lds, int wid, int lane) const {
        LAS float* Pq = (LAS float*)lds;
        FPle::Pre pre[16];
        const int row0 = u.pm * 256 + wr * 64 + fr, col0 = u.pn * 256 + wc * 32 + 8 * fq;
#pragma unroll
        for (int g = 0; g < FPle::PDIST; ++g) pre[g] = f.preload(EPG_ROW(g), EPG_COL(g));
        __builtin_amdgcn_sched_barrier(0);
        float s = 0.f;
#pragma unroll
        for (int g = 0; g < 16; ++g) { const int ai = g >> 3, m = (g >> 1) & 3, bj = g & 1;
            if (g + FPle::PDIST < 16) { pre[(g + FPle::PDIST) & 15] = f.preload(EPG_ROW(g + FPle::PDIST), EPG_COL(g + FPle::PDIST)); __builtin_amdgcn_sched_barrier(0); }
            const float v[8] = {acc[ai][bj][m][0][0], acc[ai][bj][m][0][1], acc[ai][bj][m][0][2], acc[ai][bj][m][0][3], acc[ai][bj][m][1][0], acc[ai][bj][m][1][1], acc[ai][bj][m][1][2], acc[ai][bj][m][1][3]};
            s += f.apply8sp(EPG_ROW(g), EPG_COL(g), v, pre[g]);
            if (bj == 1) { s += __shfl_xor(s, 16); s += __shfl_xor(s, 32);
                if (fq == 0) Pq[(ai * 128 + wr * 64 + m * 16 + fr) * 4 + wc] = s;
                s = 0.f; }
            __builtin_amdgcn_sched_barrier(0); }
        asm volatile("s_waitcnt lgkmcnt(0)" ::: "memory"); __builtin_amdgcn_s_barrier(); asm volatile("" ::: "memory");
        const int t = wid * 64 + lane;
        if (t < 256) { const f32x4 q = *(const LAS f32x4*)(Pq + t * 4); ssq[(size_t)(u.pm * 256 + t) * SSQW + u.pn] = (q[0] + q[1]) + (q[2] + q[3]); }
        asm volatile("s_waitcnt lgkmcnt(0)" ::: "memory"); __builtin_amdgcn_s_barrier(); asm volatile("" ::: "memory");
    }
};

__device__ __forceinline__ void ld_sc1_2x4(const float* p, f32x4& a, f32x4& b) {
    asm volatile("global_load_dwordx4 %0, %2, off sc1\n\tglobal_load_dwordx4 %1, %2, off offset:16 sc1\n\ts_waitcnt vmcnt(0)" : "=&v"(a), "=&v"(b) : "v"(p) : "memory"); }
__device__ __forceinline__ void ld_sc1_4x4(const float* p0, const float* p1, const float* p2, const float* p3, f32x4& a, f32x4& b, f32x4& c, f32x4& d) {
    asm volatile("global_load_dwordx4 %0, %4, off sc1\n\tglobal_load_dwordx4 %1, %5, off sc1\n\tglobal_load_dwordx4 %2, %6, off sc1\n\tglobal_load_dwordx4 %3, %7, off sc1\n\ts_waitcnt vmcnt(0)"
                 : "=&v"(a), "=&v"(b), "=&v"(c), "=&v"(d) : "v"(p0), "v"(p1), "v"(p2), "v"(p3) : "memory"); }
__device__ __forceinline__ void panel_rstd(const f32x4 (&acc)[2][2][4][2], const pg8::Unit& u, int wr, int wc, int fr, int fq, LAS float* Pq, LAS float* S, float* xbuf, unsigned* cnt, unsigned* tmo, int wid, int lane) {
#pragma unroll
    for (int ai = 0; ai < 2; ++ai)
#pragma unroll
        for (int m = 0; m < 4; ++m) { float s = 0.f;
#pragma unroll
            for (int bj = 0; bj < 2; ++bj)
#pragma unroll
                for (int n = 0; n < 2; ++n) { const f32x4 x = acc[ai][bj][m][n]; s += (x[0] * x[0] + x[1] * x[1]) + (x[2] * x[2] + x[3] * x[3]); }
            s += __shfl_xor(s, 16); s += __shfl_xor(s, 32);
            if (fq == 0) Pq[(ai * 128 + wr * 64 + m * 16 + fr) * 4 + wc] = s; }
    const int t = wid * 64 + lane;
    asm volatile("s_waitcnt lgkmcnt(0)" ::: "memory"); __builtin_amdgcn_s_barrier(); asm volatile("" ::: "memory");
    if (t < 256) { const f32x4 q = *(const LAS f32x4*)(Pq + t * 4);
        __hip_atomic_store(xbuf + (size_t)(u.pm * 256 + t) * 8 + u.pn, (q[0] + q[1]) + (q[2] + q[3]), __ATOMIC_RELAXED, __HIP_MEMORY_SCOPE_AGENT); }
    asm volatile("s_waitcnt vmcnt(0)" ::: "memory");
    if (wid < 4 && lane == 0) __hip_atomic_fetch_add(cnt + 64 * u.pm, 1u, __ATOMIC_RELAXED, __HIP_MEMORY_SCOPE_AGENT);
    if (wid == 0) { unsigned sp = 0u;
        while ((unsigned)__builtin_amdgcn_readfirstlane(__hip_atomic_load(cnt + 64 * u.pm, __ATOMIC_RELAXED, __HIP_MEMORY_SCOPE_AGENT)) < 32u) {
            __builtin_amdgcn_s_sleep(1);
            if ((++sp & 255u) == 0u) { if (__hip_atomic_load(tmo, __ATOMIC_RELAXED, __HIP_MEMORY_SCOPE_AGENT)) break; if (sp > (1u << 18)) { if (lane == 0) atomicAdd(tmo, 1u); break; } } }
        __builtin_amdgcn_fence(__ATOMIC_ACQUIRE, "agent"); }
    asm volatile("s_waitcnt vmcnt(0) lgkmcnt(0)" ::: "memory"); __builtin_amdgcn_s_barrier(); asm volatile("" ::: "memory");
    if (t < 256) { const float* slot = xbuf + (size_t)(u.pm * 256 + t) * 8; f32x4 a, b; ld_sc1_2x4(slot, a, b);
        const float s = ((a[0] + a[1]) + (a[2] + a[3])) + ((b[0] + b[1]) + (b[2] + b[3]));
        S[t] = rsqrtf(s * (1.f / D) + EPS); }
    asm volatile("s_waitcnt vmcnt(0) lgkmcnt(0)" ::: "memory"); __builtin_amdgcn_s_barrier(); asm volatile("" ::: "memory");
}
struct EpiPost6 {
    static constexpr bool PERM = true, AFTER_DRAIN = true;
    const bf16_t* h1; const float* g3; bf16_t* hdst; float* xbuf; unsigned* cnt; unsigned* tmo;
    struct Pre { u32x4 hh; };
    __device__ __forceinline__ Pre preload(int row, int col) const { return Pre{*(const u32x4*)(h1 + (size_t)row * D + col)}; }
    __device__ __forceinline__ void operator()(const f32x4 (&)[2][2][4][2], const pg8::Unit&, int, int, int, int) const {}
    __device__ __forceinline__ void fused(f32x4 (&acc)[2][2][4][2], const pg8::Unit& u, int wr, int wc, int fr, int fq, LAS unsigned char* lds, int wid, int lane) const {
        LAS float* Pq = (LAS float*)lds;
        LAS float* S3 = (LAS float*)(lds + 4096);
        LAS float* G3 = (LAS float*)(lds + 7168);
        const int row0 = u.pm * 256 + wr * 64 + fr, col0 = u.pn * 256 + wc * 32 + 8 * fq;
        Pre pre[16];
#pragma unroll
        for (int g = 0; g < PD6; ++g) pre[g] = preload(EPG_ROW(g), EPG_COL(g));
        const int t = wid * 64 + lane;
        if (t >= 256) G3[t - 256] = g3[u.pn * 256 + t - 256];
        panel_rstd(acc, u, wr, wc, fr, fq, Pq, S3, xbuf, cnt, tmo, wid, lane);
        __builtin_amdgcn_sched_barrier(0);
#pragma unroll
        for (int g = 0; g < 16; ++g) { const int ai = g >> 3, m = (g >> 1) & 3, bj = g & 1;
            if (g + PD6 < 16) { pre[(g + PD6) & 15] = preload(EPG_ROW(g + PD6), EPG_COL(g + PD6)); __builtin_amdgcn_sched_barrier(0); }
            const int rl = ai * 128 + wr * 64 + m * 16 + fr, cl = bj * 128 + wc * 32 + 8 * fq;
            const float r3 = S3[rl];
            const f32x4 fa = *(const LAS f32x4*)(G3 + cl) * r3, fb = *(const LAS f32x4*)(G3 + cl + 4) * r3;
            float hh[8], v[8]; unpack8(pre[g].hh, hh);
#pragma unroll
            for (int j = 0; j < 4; ++j) { v[j] = hh[j] + acc[ai][bj][m][0][j] * fa[j]; v[4 + j] = hh[4 + j] + acc[ai][bj][m][1][j] * fb[j]; }
            *(u32x4*)(hdst + (size_t)EPG_ROW(g) * D + EPG_COL(g)) = pack8(v);
            __builtin_amdgcn_sched_barrier(0); }
    }
};
struct EpiPost4 {
    static constexpr bool PERM = true, AFTER_DRAIN = true;
    const bf16_t* h; const float* g1; bf16_t* h1dst; float* ssq2; float* xbuf; unsigned* cnt; unsigned* tmo;
    struct Pre { u32x4 hh; };
    __device__ __forceinline__ Pre preload(int row, int col) const { return Pre{*(const u32x4*)(h + (size_t)row * D + col)}; }
    __device__ __forceinline__ void operator()(const f32x4 (&)[2][2][4][2], const pg8::Unit&, int, int, int, int) const {}
    __device__ __forceinline__ void fused(f32x4 (&acc)[2][2][4][2], const pg8::Unit& u, int wr, int wc, int fr, int fq, LAS unsigned char* lds, int wid, int lane) const {
        LAS float* Pq = (LAS float*)lds;
        LAS float* S1 = (LAS float*)(lds + 4096);
        LAS float* G1 = (LAS float*)(lds + 7168);
        const int row0 = u.pm * 256 + wr * 64 + fr, col0 = u.pn * 256 + wc * 32 + 8 * fq;
        Pre pre[16];
#pragma unroll
        for (int g = 0; g < PD6; ++g) pre[g] = preload(EPG_ROW(g), EPG_COL(g));
        const int t = wid * 64 + lane;
        if (t >= 256) G1[t - 256] = g1[u.pn * 256 + t - 256];
        panel_rstd(acc, u, wr, wc, fr, fq, Pq, S1, xbuf, cnt, tmo, wid, lane);
        __builtin_amdgcn_sched_barrier(0);
        float s2 = 0.f;
#pragma unroll
        for (int g = 0; g < 16; ++g) { const int ai = g >> 3, m = (g >> 1) & 3, bj = g & 1;
            if (g + PD6 < 16) { pre[(g + PD6) & 15] = preload(EPG_ROW(g + PD6), EPG_COL(g + PD6)); __builtin_amdgcn_sched_barrier(0); }
            const int rl = ai * 128 + wr * 64 + m * 16 + fr, cl = bj * 128 + wc * 32 + 8 * fq;
            const float r1 = S1[rl];
            const f32x4 ga = *(const LAS f32x4*)(G1 + cl) * r1, gb = *(const LAS f32x4*)(G1 + cl + 4) * r1;
            float hh[8], v[8]; unpack8(pre[g].hh, hh);
#pragma unroll
            for (int j = 0; j < 4; ++j) { v[j] = hh[j] + acc[ai][bj][m][0][j] * ga[j]; v[4 + j] = hh[4 + j] + acc[ai][bj][m][1][j] * gb[j]; }
#pragma unroll
            for (int j = 0; j < 8; ++j) s2 += v[j] * v[j];
            *(u32x4*)(h1dst + (size_t)EPG_ROW(g) * D + EPG_COL(g)) = pack8(v);
            if (bj == 1) { s2 += __shfl_xor(s2, 16); s2 += __shfl_xor(s2, 32);
                if (fq == 0) Pq[rl * 4 + wc] = s2;
                s2 = 0.f; }
            __builtin_amdgcn_sched_barrier(0); }
        asm volatile("s_waitcnt lgkmcnt(0)" ::: "memory"); __builtin_amdgcn_s_barrier(); asm volatile("" ::: "memory");
        if (t < 256) { const f32x4 q = *(const LAS f32x4*)(Pq + t * 4); ssq2[(size_t)(u.pm * 256 + t) * 8 + u.pn] = (q[0] + q[1]) + (q[2] + q[3]); }
        asm volatile("s_waitcnt lgkmcnt(0)" ::: "memory"); __builtin_amdgcn_s_barrier(); asm volatile("" ::: "memory");
    }
};

__device__ __forceinline__ void transpose_item(const float* W, int ldw, const float* kgain, float scale, bf16_t* WT, int ldt, int k0, int n_src0, int n_dst0, LAS float* scr, int lane) {
    float wv[32];
#pragma unroll
    for (int i = 0; i < 32; ++i) wv[i] = W[(size_t)(k0 + 2 * i + (lane >> 5)) * ldw + n_src0 + (lane & 31)];
    if (kgain) {
#pragma unroll
        for (int i = 0; i < 32; ++i) wv[i] *= kgain[k0 + 2 * i + (lane >> 5)] * scale; }
#pragma unroll
    for (int i = 0; i < 32; ++i) scr[(2 * i + (lane >> 5)) * 33 + (lane & 31)] = wv[i];
    asm volatile("s_waitcnt lgkmcnt(0)" ::: "memory");
    const int c = lane & 7;
#pragma unroll
    for (int j = 0; j < 4; ++j) { const int n = (lane >> 3) + 8 * j; const LAS float* s = scr + (8 * c) * 33 + n;
        u32x4 o; o.x = pk2(s[0 * 33], s[1 * 33]); o.y = pk2(s[2 * 33], s[3 * 33]); o.z = pk2(s[4 * 33], s[5 * 33]); o.w = pk2(s[6 * 33], s[7 * 33]);
        *(u32x4*)(WT + (size_t)(n_dst0 + n) * ldt + k0 + 8 * c) = o; }
    asm volatile("s_waitcnt lgkmcnt(0)" ::: "memory");
}
__device__ __forceinline__ void fold_item(const float* Win, const float* wgg, const float* kgain, bf16_t* WT, int k0, int j0, int n_dst0, LAS float* scr, int lane) {
    float wg[GR];
#pragma unroll
    for (int r = 0; r < GR; ++r) wg[r] = wgg[r * GKW + j0 + (lane & 31)];
#pragma unroll 8
    for (int i = 0; i < 32; ++i) { const int kk = 2 * i + (lane >> 5); const f32x4* wr = (const f32x4*)(Win + (size_t)(k0 + kk) * NIN + C_GLR); float s = 0.f;
#pragma unroll
        for (int r4 = 0; r4 < GR / 4; ++r4) { const f32x4 x = wr[r4]; s += (x[0] * wg[4 * r4] + x[1] * wg[4 * r4 + 1]) + (x[2] * wg[4 * r4 + 2] + x[3] * wg[4 * r4 + 3]); }
        scr[kk * 33 + (lane & 31)] = s * kgain[k0 + kk]; }
    asm volatile("s_waitcnt lgkmcnt(0)" ::: "memory");
    const int c = lane & 7;
#pragma unroll
    for (int j = 0; j < 4; ++j) { const int n = (lane >> 3) + 8 * j; const LAS float* s = scr + (8 * c) * 33 + n;
        u32x4 o; o.x = pk2(s[0 * 33], s[1 * 33]); o.y = pk2(s[2 * 33], s[3 * 33]); o.z = pk2(s[4 * 33], s[5 * 33]); o.w = pk2(s[6 * 33], s[7 * 33]);
        *(u32x4*)(WT + (size_t)(n_dst0 + n) * D + k0 + 8 * c) = o; }
    asm volatile("s_waitcnt lgkmcnt(0)" ::: "memory");
}

__device__ __forceinline__ void phase_prologue(const P& p, unsigned char* ws, LAS unsigned char* lds, int wg, int nwg) {
    const int tid = tidx(), lane = tid & 63, wave = tid >> 6;
    LAS float* scr = (LAS float*)(lds + wave * 16384);
    const int gw = wg * NWAVES + wave, NGW = nwg * NWAVES;
    constexpr int I_IN = (D / 64) * (NZ / 32), I_UH = (HW / 64) * (D / 32), I_UG = I_UH, I_OUT = (D / 64) * (D / 32), I_F1 = (D / 64) * (DFF / 32), I_F2 = (DFF / 64) * (D / 32), I_PL = (PLE / 64) * (D / 32), I_PG = I_OUT;
    constexpr int I_LAYER = I_IN + I_UH + I_UG + I_OUT + I_F1 + I_F2 + I_PL + I_PG;
    for (int it = gw; it < DEPTH * I_LAYER; it += NGW) {
        const int l = it / I_LAYER; int r = it % I_LAYER;
        if (r < I_IN) { const int nb = r % (NZ / 32), kb = r / (NZ / 32), n0 = nb * 32; bf16_t* WT = (bf16_t*)(ws + WS_WIN) + (size_t)l * NZ * D; const float* Win = p.w_in + (size_t)l * D * NIN; const float* kg = p.n_pre_mix + l * D;
            if (n0 >= 7168 && n0 < 7680) fold_item(Win, p.wgg + (size_t)l * GR * GKW, kg, WT, kb * 64, n0 - 7168, n0, scr, lane);
            else { const int ns = n0 < 7168 ? n0 : n0 - 496; const float sc = (n0 >= 4096 && n0 < 4608) ? 0.08838834764831845f : 1.f; transpose_item(Win, NIN, kg, sc, WT, D, kb * 64, ns, n0, scr, lane); }
            continue; } r -= I_IN;
        if (r < I_UH) { transpose_item(p.w_hup + (size_t)l * HW * D, D, nullptr, 1.f, (bf16_t*)(ws + WS_WUH) + (size_t)l * D * HW, HW, (r / (D / 32)) * 64, (r % (D / 32)) * 32, (r % (D / 32)) * 32, scr, lane); continue; } r -= I_UH;
        if (r < I_UG) { transpose_item(p.w_gup + (size_t)l * GVW * D, D, nullptr, 1.f, (bf16_t*)(ws + WS_WUG) + (size_t)l * D * GVW, GVW, (r / (D / 32)) * 64, (r % (D / 32)) * 32, (r % (D / 32)) * 32, scr, lane); continue; } r -= I_UG;
        if (r < I_OUT) { transpose_item(p.w_out + (size_t)l * D * D, D, nullptr, 1.f, (bf16_t*)(ws + WS_WOUT) + (size_t)l * D * D, D, (r / (D / 32)) * 64, (r % (D / 32)) * 32, (r % (D / 32)) * 32, scr, lane); continue; } r -= I_OUT;
        if (r < I_F1) { transpose_item(p.w_ff1 + (size_t)l * D * DFF, DFF, p.n_pre_ffn + l * D, 1.f, (bf16_t*)(ws + WS_WFF1) + (size_t)l * DFF * D, D, (r / (DFF / 32)) * 64, (r % (DFF / 32)) * 32, (r % (DFF / 32)) * 32, scr, lane); continue; } r -= I_F1;
        if (r < I_F2) { transpose_item(p.w_ff2 + (size_t)l * DFF * D, D, nullptr, 1.f, (bf16_t*)(ws + WS_WFF2) + (size_t)l * D * DFF, DFF, (r / (D / 32)) * 64, (r % (D / 32)) * 32, (r % (D / 32)) * 32, scr, lane); continue; } r -= I_F2;
        if (r < I_PL) { transpose_item(p.w_ple + (size_t)l * PLE * D, D, nullptr, 1.f, (bf16_t*)(ws + WS_WPLE) + (size_t)l * D * PLE, PLE, (r / (D / 32)) * 64, (r % (D / 32)) * 32, (r % (D / 32)) * 32, scr, lane); continue; } r -= I_PL;
        transpose_item(p.w_plg + (size_t)l * D * D, D, nullptr, 1.f, (bf16_t*)(ws + WS_WPLG) + (size_t)l * D * D, D, (r / (D / 32)) * 64, (r % (D / 32)) * 32, (r % (D / 32)) * 32, scr, lane);
    }
    float* lbs = (float*)(ws + WS_LBS);
    for (int c = wg * NTHR + tid; c < HW; c += nwg * NTHR) {
        float e[DEPTH], mx = -1e30f, sum = 0.f;
#pragma unroll
        for (int i = 0; i < DEPTH; ++i) { e[i] = p.lbp[i * HW + c]; mx = fmaxf(mx, e[i]); }
#pragma unroll
        for (int i = 0; i < DEPTH; ++i) { e[i] = __expf(e[i] - mx); sum += e[i]; }
        float acc = 0.f; lbs[c] = 0.f;
#pragma unroll
        for (int i = 1; i < DEPTH; ++i) { acc += e[i]; lbs[i * HW + c] = acc / sum; }
    }
    { bf16_t* pbf = (bf16_t*)(ws + WS_PBF);
      constexpr size_t NPP = (size_t)DEPTH * MP * PLE, NPS = (size_t)DEPTH * DECB * PLE;
      for (size_t i = ((size_t)wg * NTHR + tid) * 4; i < NPP + NPS; i += (size_t)nwg * NTHR * 4) {
          const float* src = i < NPP ? p.pp + i : p.ps + (i - NPP);
          const f32x4 v = *(const f32x4*)src; u32x2 w; w.x = pk2(v[0], v[1]); w.y = pk2(v[2], v[3]); *(u32x2*)(pbf + i) = w; } }
    bf16_t* hbf = (bf16_t*)(ws + WS_HBF); float* ssq = (float*)(ws + WS_SSQ);
    for (int row = gw; row < MT; row += NGW) {
        const float* src = row < MP ? p.xp + (size_t)row * D : p.xs + (size_t)(row - MP) * D; float s = 0.f;
#pragma unroll
        for (int j = 0; j < 8; ++j) { const f32x4 v = *(const f32x4*)(src + j * 256 + lane * 4); s += (v[0] * v[0] + v[1] * v[1]) + (v[2] * v[2] + v[3] * v[3]);
            u32x2 w; w.x = pk2(v[0], v[1]); w.y = pk2(v[2], v[3]); *(u32x2*)(hbf + (size_t)row * D + j * 256 + lane * 4) = w; }
        s = wave_sum(s);
        if (lane < SSQW) ssq[(size_t)row * SSQW + lane] = lane == 0 ? s : 0.f;
    }
}

constexpr size_t WS_T4 = WS_T32, WS_T6 = WS_T32 + (size_t)MR * D * 2;
constexpr size_t WS_PART4 = WS_PART, WS_PART6 = WS_PART + (size_t)4 * DECB * D * 4;
__device__ __forceinline__ float ssq4(const f32x4 x) { return (x[0] * x[0] + x[1] * x[1]) + (x[2] * x[2] + x[3] * x[3]); }
__device__ __forceinline__ f32x4 unpk4(const u32x2 w) { return (f32x4){__uint_as_float(w.x << 16), __uint_as_float(w.x & 0xffff0000u), __uint_as_float(w.y << 16), __uint_as_float(w.y & 0xffff0000u)}; }
template <int MODE> __device__ __forceinline__ void thin_post(unsigned char* ws, LAS unsigned char* lds, const bf16_t* hcur, const float* g1, const float* g2, const float* g3, bf16_t* hbf_dst, int wg, int nwg) {
    const int lane = tidx() & 63, wave = tidx() >> 6;
    LAS float* red = (LAS float*)lds;
    for (int r = wg; r < DECB; r += nwg) {
        const int row = MP + r, col = wave * 256 + lane * 4;
        const float* p4 = (const float*)(ws + WS_PART4) + (size_t)r * D + col; f32x4 t = *(const f32x4*)p4;
        f32x4 u = (f32x4){0.f, 0.f, 0.f, 0.f};
        if constexpr (MODE == 1) { const float* p6 = (const float*)(ws + WS_PART6) + (size_t)r * D + col; u = *(const f32x4*)p6;
#pragma unroll
            for (int ks = 1; ks < 4; ++ks) u += *(const f32x4*)(p6 + (size_t)ks * DECB * D); }
        const f32x4 h = unpk4(*(const u32x2*)(hcur + (size_t)row * D + col));
        const float s1 = wave_sum(ssq4(t)), s3 = wave_sum(ssq4(u));
        __syncthreads();
        if (lane == 0) { red[wave] = s1; red[8 + wave] = s3; }
        __syncthreads();
        float S1 = 0.f, S3 = 0.f;
#pragma unroll
        for (int k = 0; k < 8; ++k) { S1 += red[k]; S3 += red[8 + k]; }
        const float rs1 = rsqrtf(S1 * (1.f / D) + EPS);
        const f32x4 h1 = h + t * rs1 * *(const f32x4*)(g1 + col);
        if constexpr (MODE == 0) {
            const float s2 = wave_sum(ssq4(h1));
            if (lane == 0) red[16 + wave] = s2;
            __syncthreads();
            float S2 = 0.f;
#pragma unroll
            for (int k = 0; k < 8; ++k) S2 += red[16 + k];
            u32x2 w; w.x = pk2(h1[0], h1[1]); w.y = pk2(h1[2], h1[3]); *(u32x2*)((bf16_t*)(ws + WS_T4) + (size_t)row * D + col) = w;
            if (tidx() < 8) ((float*)(ws + WS_CTL))[CW_SSQ2 + (size_t)row * 8 + tidx()] = tidx() == 0 ? S2 : 0.f;
        } else {
            const f32x4 h2 = h1 + u * rsqrtf(S3 * (1.f / D) + EPS) * *(const f32x4*)(g3 + col);
            u32x2 w; w.x = pk2(h2[0], h2[1]); w.y = pk2(h2[2], h2[3]); *(u32x2*)(hbf_dst + (size_t)row * D + col) = w;
        }
    }
}

constexpr size_t OUT_HP = (size_t)MT * D;
constexpr size_t OUT_GP = OUT_HP + (size_t)DEPTH * BATCH * HH * HK * HV;
constexpr size_t OUT_HS = OUT_GP + (size_t)DEPTH * BATCH * GH * GK * GV;
constexpr size_t OUT_GS = OUT_HS + (size_t)DEPTH * DECB * HH * HK * HV;
constexpr int SQ = 272, SK = 144;
constexpr int R_QA = 0, R_PP = R_QA + 64 * SQ, R_KBT = R_PP + 64 * SK, R_DEC = R_KBT + 128 * SK, IMG_BYTES = R_DEC + 512;
constexpr int R_VT = IMG_BYTES, R_ST0 = R_VT + 64 * SK, R_ST1 = R_ST0 + 64 * SQ, R_END = R_ST1 + 64 * SQ;
constexpr int R_OSQ = R_END, R_ORS = R_OSQ + SEQ * 2 * 4, R_OEND = R_ORS + SEQ * 4;
static_assert(R_OEND <= 131072, "recurrence LDS map (head-norm tables)");
constexpr int RP_KA = IMG_BYTES, RP_SEG = RP_KA + 64 * SQ;
static_assert(R_END <= 131072 && IMG_BYTES % 256 == 0, "recurrence LDS / image map");
constexpr int NSH = BATCH * HH + BATCH * GH;
constexpr size_t WS_IMG = WS_MRG;
constexpr size_t WS_EMID = WS_IMG + (size_t)NSH * 32 * IMG_BYTES;
constexpr size_t WS_XO = WS_EMID + (size_t)NSH * 32 * 128 * 4;
static_assert(WS_XO + (size_t)NSH * 4 * SEQ * 4 <= WS_MRG + (size_t)MR * D * 2 + (size_t)MR * DFF * 2, "chunk images + head-norm exchange fit in MRG | U");
constexpr int CW_TMO = 1024 + 128;
constexpr int CW_OCNT = 231424;
static_assert((size_t)(CW_OCNT + DEPTH * NSH * 64) * 4 <= CTL_BYTES && CW_OCNT >= CW_SSQ2 + MR * 8, "head-norm counters");
typedef short bf16x8_t __attribute__((ext_vector_type(8)));
#define MFMA16(a, b, c) __builtin_amdgcn_mfma_f32_16x16x32_bf16((a), (b), (c), 0, 0, 0)

__device__ __forceinline__ void rec_prep_task(unsigned char* ws, LAS unsigned char* lds, int tkp) {
    const int tid = tidx();
    const int shg = tkp >> 5, ch = tkp & 31; const bool gla = shg >= BATCH * HH; const int sh = gla ? shg - BATCH * HH : shg;
    const int nheads = gla ? GH : HH, b = sh / nheads, head = sh % nheads, ldk = gla ? GKW : HW;
    const size_t row0 = (size_t)(b * SEQ + ch * 64);
    const bf16_t* qp = (const bf16_t*)(ws + (gla ? WS_QG : WS_QH)) + row0 * ldk + head * 128;
    const bf16_t* kp = (const bf16_t*)(ws + (gla ? WS_KG : WS_KH)) + row0 * ldk + head * 128;
    const float* gp = (const float*)(ws + (gla ? WS_LOGA : WS_LOGF)) + row0 * ldk + head * 128;
    unsigned char* img = ws + WS_IMG + (size_t)tkp * IMG_BYTES;
    const int c = tid & 127, tq = tid >> 7;
    float gr[16]; bf16_t qr[16], kr[16];
#pragma unroll
    for (int i = 0; i < 16; ++i) { const size_t t = (size_t)(tq * 16 + i); gr[i] = gp[t * ldk + c]; qr[i] = qp[t * ldk + c]; kr[i] = kp[t * ldk + c]; }
    float pf[16]; float run = 0.f;
#pragma unroll
    for (int i = 0; i < 16; ++i) { run += gr[i]; pf[i] = run; }
    __syncthreads();
    ((LAS float*)(lds + RP_SEG))[tq * 128 + c] = run;
    __syncthreads();
    const float s0 = ((LAS float*)(lds + RP_SEG))[c], s1 = ((LAS float*)(lds + RP_SEG))[128 + c], s2 = ((LAS float*)(lds + RP_SEG))[256 + c], s3 = ((LAS float*)(lds + RP_SEG))[384 + c];
    const float off = tq == 0 ? 0.f : (tq == 1 ? s0 : (tq == 2 ? s0 + s1 : s0 + s1 + s2));
    const float bmid = s0 + s1, blast = (s0 + s1) + (s2 + s3);
    const float Elm = __expf(blast - bmid);
    if (tq == 0) { ((LAS float*)(lds + R_DEC))[c] = __expf(blast); ((float*)(ws + WS_EMID))[(size_t)tkp * 128 + c] = __expf(bmid); }
    float kb[16];
#pragma unroll
    for (int i = 0; i < 16; ++i) {
        const int t = tq * 16 + i;
        const float x = clampf(off + pf[i] - bmid, -60.f, 60.f);
        const float e1 = __expf(x), r1 = __builtin_amdgcn_rcpf(e1);
        const float qa = bf2f(qr[i]) * e1, ka = bf2f(kr[i]) * r1;
        *(LAS bf16_t*)(lds + R_QA + t * SQ + c * 2) = (bf16_t)pk2(qa, 0.f);
        *(LAS bf16_t*)(lds + RP_KA + t * SQ + c * 2) = (bf16_t)pk2(ka, 0.f);
        kb[i] = ka * Elm;
    }
    { u32x4 w0, w1; w0.x = pk2(kb[0], kb[1]); w0.y = pk2(kb[2], kb[3]); w0.z = pk2(kb[4], kb[5]); w0.w = pk2(kb[6], kb[7]);
      w1.x = pk2(kb[8], kb[9]); w1.y = pk2(kb[10], kb[11]); w1.z = pk2(kb[12], kb[13]); w1.w = pk2(kb[14], kb[15]);
      *(LAS u32x4*)(lds + R_KBT + c * SK + tq * 32) = w0; *(LAS u32x4*)(lds + R_KBT + c * SK + tq * 32 + 16) = w1; }
    __syncthreads();
    {
        const int lane = tid & 63, w = tid >> 6, fr = lane & 15, fq = lane >> 4, ti = w >> 1, vi = w & 1;
        bf16x8_t qf[4];
#pragma unroll
        for (int kk = 0; kk < 4; ++kk) qf[kk] = *(const LAS bf16x8_t*)(lds + R_QA + (ti * 16 + fr) * SQ + kk * 64 + fq * 16);
#pragma unroll
        for (int sj = 0; sj < 2; ++sj) { const int si = 2 * vi + sj; f32x4 acc = (f32x4){0.f, 0.f, 0.f, 0.f};
#pragma unroll
            for (int kk = 0; kk < 4; ++kk) { const bf16x8_t a = *(const LAS bf16x8_t*)(lds + RP_KA + (si * 16 + fr) * SQ + kk * 64 + fq * 16); acc = MFMA16(a, qf[kk], acc); }
            const int t = ti * 16 + fr, sb = si * 16 + fq * 4;
            u32x2 wv; wv.x = pk2(sb <= t ? acc[0] : 0.f, sb + 1 <= t ? acc[1] : 0.f); wv.y = pk2(sb + 2 <= t ? acc[2] : 0.f, sb + 3 <= t ? acc[3] : 0.f);
            *(LAS u32x2*)(lds + R_PP + t * SK + sb * 2) = wv; }
    }
    __syncthreads();
    for (int i = tid; i < IMG_BYTES / 16; i += NTHR) *(u32x4*)(img + (size_t)i * 16) = *(const LAS u32x4*)(lds + i * 16);
}

__device__ __forceinline__ void rec_loop_task(const P& p, unsigned char* ws, int l, LAS unsigned char* lds, int tk) {
    const int tid = tidx(), lane = tid & 63, w = __builtin_amdgcn_readfirstlane(tid >> 6), fr = lane & 15, fq = lane >> 4;
    const int xcd = tk & 7, jx = tk >> 3;
    const bool gla = jx >= 8;
    const int sh = gla ? xcd + 8 * ((jx - 8) >> 2) : xcd + 8 * (jx >> 1), vs = gla ? ((jx - 8) & 3) : (jx & 1), V = gla ? GV : HV, nheads = gla ? GH : HH, b = sh / nheads, head = sh % nheads;
    const int shg = gla ? sh + BATCH * HH : sh;
    const unsigned char* img0 = ws + WS_IMG + (size_t)shg * 32 * IMG_BYTES;
    const float* em0 = (const float*)(ws + WS_EMID) + (size_t)shg * 32 * 128 + (w >> 1) * 32 + fq * 4;
    const bf16_t* vp = (const bf16_t*)(ws + (gla ? WS_VG : WS_VH)) + (size_t)(b * SEQ) * 1024 + head * V + vs * 64;
    float* op = (float*)(ws + WS_T32) + (size_t)(b * SEQ) * D + (gla ? 1024 : 0) + head * V + vs * 64;
    float* sp = p.out + (gla ? OUT_GP : OUT_HP) + (size_t)l * BATCH * nheads * 128 * V + ((size_t)sh * 128) * V + vs * 64;
    const int ti = w >> 1, vi = w & 1;
    f32x4 Sacc[2][2];
#pragma unroll
    for (int cj = 0; cj < 2; ++cj)
#pragma unroll
        for (int oj = 0; oj < 2; ++oj) Sacc[cj][oj] = (f32x4){0.f, 0.f, 0.f, 0.f};
    __syncthreads();
    for (int i = tid; i < 64 * SQ / 4; i += NTHR) ((LAS unsigned*)(lds + R_ST0))[i] = 0u;
    constexpr int NCORE = IMG_BYTES / 16;
    u32x4 pre[7], pre2[7]; f32x4 em1[2], em2[2];
    int pidx[6];
#pragma unroll
    for (int i = 0; i < 6; ++i) { const int pi_ = tid + i * NTHR; pidx[i] = pi_ < NCORE ? pi_ : NCORE - 1; }
    const int vt_t = ((tid >> 6) & 1) * 32 + (tid & 31), vt_q = (tid >> 7) * 2 + ((tid >> 5) & 1);
#define REC_FETCH(pre, em, chn) do { const unsigned char* im_ = img0 + (size_t)(chn) * IMG_BYTES; \
        _Pragma("unroll") for (int i = 0; i < 6; ++i) pre[i] = *(const u32x4*)(im_ + (size_t)pidx[i] * 16);     \
        pre[6] = *(const u32x4*)(vp + (size_t)((chn) * 64 + vt_t) * 1024 + vt_q * 8); \
        { const float* e_ = em0 + (size_t)((chn) + 1 < SEQ / 64 ? (chn) + 1 : (chn)) * 128; em[0] = *(const f32x4*)e_; em[1] = *(const f32x4*)(e_ + 16); } } while (0)
#define REC_STAGE(pre) do { _Pragma("unroll") for (int i = 0; i < 6; ++i) *(LAS u32x4*)(lds + pidx[i] * 16) = pre[i]; \
        { const unsigned wv_[4] = {pre[6].x, pre[6].y, pre[6].z, pre[6].w}; \
          _Pragma("unroll") for (int i = 0; i < 4; ++i) { *(LAS bf16_t*)(lds + R_VT + (vt_q * 8 + 2 * i) * SK + vt_t * 2) = (bf16_t)(wv_[i] & 0xffffu); *(LAS bf16_t*)(lds + R_VT + (vt_q * 8 + 2 * i + 1) * SK + vt_t * 2) = (bf16_t)(wv_[i] >> 16); } } } while (0)
    REC_FETCH(pre, em1, 0); REC_FETCH(pre2, em2, 1);
    for (int ch = 0; ch < SEQ / 64; ch += 2) {
#pragma unroll
      for (int half = 0; half < 2; ++half) {
        const int st_rd = half ? R_ST1 : R_ST0, st_wr = half ? R_ST0 : R_ST1;
        __syncthreads();
        f32x4 emn[2];
        if (half == 0) { REC_STAGE(pre); emn[0] = em1[0]; emn[1] = em1[1]; REC_FETCH(pre, em1, (ch + 2 < SEQ / 64 ? ch + 2 : SEQ / 64 - 1)); }
        else { REC_STAGE(pre2); emn[0] = em2[0]; emn[1] = em2[1]; REC_FETCH(pre2, em2, (ch + 3 < SEQ / 64 ? ch + 3 : SEQ / 64 - 1)); }
        __syncthreads();
        f32x4 oacc[2] = {(f32x4){0.f, 0.f, 0.f, 0.f}, (f32x4){0.f, 0.f, 0.f, 0.f}};
        __builtin_amdgcn_s_setprio(1);
#pragma unroll
        for (int kk = 0; kk < 4; ++kk) { const bf16x8_t qf = *(const LAS bf16x8_t*)(lds + R_QA + (ti * 16 + fr) * SQ + kk * 64 + fq * 16);
#pragma unroll
            for (int oj = 0; oj < 2; ++oj) { const bf16x8_t bb = *(const LAS bf16x8_t*)(lds + st_rd + ((2 * vi + oj) * 16 + fr) * SQ + kk * 64 + fq * 16); oacc[oj] = MFMA16(bb, qf, oacc[oj]); } }
        bf16x8_t vf[2][2];
#pragma unroll
        for (int oj = 0; oj < 2; ++oj)
#pragma unroll
            for (int kk = 0; kk < 2; ++kk) vf[oj][kk] = *(const LAS bf16x8_t*)(lds + R_VT + ((2 * vi + oj) * 16 + fr) * SK + kk * 64 + fq * 16);
#pragma unroll
        for (int kk = 0; kk < 2; ++kk) { const bf16x8_t a = *(const LAS bf16x8_t*)(lds + R_PP + (ti * 16 + fr) * SK + kk * 64 + fq * 16);
#pragma unroll
            for (int oj = 0; oj < 2; ++oj) oacc[oj] = MFMA16(vf[oj][kk], a, oacc[oj]); }
#pragma unroll
        for (int cj = 0; cj < 2; ++cj) { const int ct = 2 * ti + cj;
            const f32x4 dc = *(const LAS f32x4*)(lds + R_DEC + (ct * 16 + fq * 4) * 4);
#pragma unroll
            for (int oj = 0; oj < 2; ++oj) Sacc[cj][oj] = Sacc[cj][oj] * dc;
#pragma unroll
            for (int kk = 0; kk < 2; ++kk) { const bf16x8_t kf = *(const LAS bf16x8_t*)(lds + R_KBT + (ct * 16 + fr) * SK + kk * 64 + fq * 16);
#pragma unroll
                for (int oj = 0; oj < 2; ++oj) Sacc[cj][oj] = MFMA16(kf, vf[oj][kk], Sacc[cj][oj]); } }
        __builtin_amdgcn_s_setprio(0);
#pragma unroll
        for (int oj = 0; oj < 2; ++oj) *(f32x4*)(op + (size_t)((ch + half) * 64 + ti * 16 + fr) * D + (2 * vi + oj) * 16 + fq * 4) = oacc[oj];
        { const f32x4 q2 = oacc[0] * oacc[0] + oacc[1] * oacc[1]; float x = (q2[0] + q2[1]) + (q2[2] + q2[3]);
          x += __shfl_xor(x, 16); x += __shfl_xor(x, 32);
          if (fq == 0) ((LAS float*)(lds + R_OSQ))[((ch + half) * 64 + ti * 16 + fr) * 2 + vi] = x; }
#pragma unroll
        for (int cj = 0; cj < 2; ++cj)
#pragma unroll
            for (int oj = 0; oj < 2; ++oj) { u32x2 wv; wv.x = pk2(Sacc[cj][oj][0] * emn[cj][0], Sacc[cj][oj][1] * emn[cj][1]); wv.y = pk2(Sacc[cj][oj][2] * emn[cj][2], Sacc[cj][oj][3] * emn[cj][3]);
                *(LAS u32x2*)(lds + st_wr + ((2 * vi + oj) * 16 + fr) * SQ + ((2 * ti + cj) * 16 + fq * 4) * 2) = wv; }
      }
    }
#undef REC_FETCH
#undef REC_STAGE
#pragma unroll
    for (int cj = 0; cj < 2; ++cj)
#pragma unroll
        for (int oj = 0; oj < 2; ++oj)
#pragma unroll
            for (int j = 0; j < 4; ++j) sp[(size_t)((2 * ti + cj) * 16 + fq * 4 + j) * V + (2 * vi + oj) * 16 + fr] = Sacc[cj][oj][j];
    const int nsl = V / 64;
    float* xo = (float*)(ws + WS_XO) + (size_t)shg * 4 * SEQ;
    unsigned* ocnt = (unsigned*)(ws + WS_CTL) + CW_OCNT + (l * NSH + shg) * 64;
    unsigned* tmo = (unsigned*)(ws + WS_CTL) + CW_TMO;
    __syncthreads();
    { const f32x4 a = *(const LAS f32x4*)(lds + R_OSQ + tid * 32), bq = *(const LAS f32x4*)(lds + R_OSQ + tid * 32 + 16);
      float* slot = xo + (size_t)vs * SEQ + tid * 4;
      __hip_atomic_store(slot + 0, a[0] + a[1], __ATOMIC_RELAXED, __HIP_MEMORY_SCOPE_AGENT); __hip_atomic_store(slot + 1, a[2] + a[3], __ATOMIC_RELAXED, __HIP_MEMORY_SCOPE_AGENT);
      __hip_atomic_store(slot + 2, bq[0] + bq[1], __ATOMIC_RELAXED, __HIP_MEMORY_SCOPE_AGENT); __hip_atomic_store(slot + 3, bq[2] + bq[3], __ATOMIC_RELAXED, __HIP_MEMORY_SCOPE_AGENT); }
    asm volatile("s_waitcnt vmcnt(0)" ::: "memory");
    __syncthreads();
    if (w == 0) {
        if (lane == 0) __hip_atomic_fetch_add(ocnt, 1u, __ATOMIC_RELAXED, __HIP_MEMORY_SCOPE_AGENT);
        unsigned sp_ = 0u;
        while ((unsigned)__builtin_amdgcn_readfirstlane(__hip_atomic_load(ocnt, __ATOMIC_RELAXED, __HIP_MEMORY_SCOPE_AGENT)) < (unsigned)nsl) {
            __builtin_amdgcn_s_sleep(1);
            if ((++sp_ & 255u) == 0u) { if (__hip_atomic_load(tmo, __ATOMIC_RELAXED, __HIP_MEMORY_SCOPE_AGENT)) break; if (sp_ > (1u << 18)) { if (lane == 0) atomicAdd(tmo, 1u); break; } } }
        __builtin_amdgcn_fence(__ATOMIC_ACQUIRE, "agent"); }
    __syncthreads();
    { f32x4 qa, qb, qc, qd; const float* x0 = xo + tid * 4;
      ld_sc1_4x4(x0, x0 + SEQ, x0 + 2 * SEQ, x0 + 3 * SEQ, qa, qb, qc, qd);
      float s4[4];
#pragma unroll
      for (int j = 0; j < 4; ++j) s4[j] = (qa[j] + qb[j]) + (nsl > 2 ? qc[j] + qd[j] : 0.f);
      const float iv = gla ? (1.f / GV) : (1.f / HV);
      *(LAS f32x4*)(lds + R_ORS + tid * 16) = (f32x4){rsqrtf(s4[0] * iv + EPS), rsqrtf(s4[1] * iv + EPS), rsqrtf(s4[2] * iv + EPS), rsqrtf(s4[3] * iv + EPS)}; }
    __syncthreads();
    { const int c4 = (tid & 15) * 4, r0 = tid >> 4;
      const f32x4 gn4 = *(const f32x4*)((gla ? p.gln + l * GV : p.hgn + l * HV) + vs * 64 + c4);
      const bf16_t* gate = (const bf16_t*)(ws + (gla ? WS_RG : WS_GHG)) + (size_t)(b * SEQ) * 1024 + head * V + vs * 64 + c4;
      bf16_t* og = (bf16_t*)(ws + WS_OG) + (size_t)(b * SEQ) * D + (gla ? 1024 : 0) + head * V + vs * 64 + c4;
      const float* orow = op + c4;
#pragma nounroll
      for (int rb = 0; rb < SEQ; rb += 256) {
          f32x4 ov[8]; u32x2 gw[8];
#pragma unroll
          for (int i = 0; i < 8; ++i) { const int r = rb + i * 32 + r0; ov[i] = *(const f32x4*)(orow + (size_t)r * D); gw[i] = *(const u32x2*)(gate + (size_t)r * 1024); }
#pragma unroll
          for (int i = 0; i < 8; ++i) { const int r = rb + i * 32 + r0; const float rs = ((const LAS float*)(lds + R_ORS))[r];
              const float g0 = __uint_as_float(gw[i].x << 16), g1 = __uint_as_float(gw[i].x & 0xffff0000u), g2 = __uint_as_float(gw[i].y << 16), g3 = __uint_as_float(gw[i].y & 0xffff0000u);
              u32x2 wv; wv.x = pk2(ov[i][0] * rs * gn4[0] * g0, ov[i][1] * rs * gn4[1] * g1); wv.y = pk2(ov[i][2] * rs * gn4[2] * g2, ov[i][3] * rs * gn4[3] * g3);
              *(u32x2*)(og + (size_t)r * D) = wv; } } }
    __syncthreads();
}

template <int V, bool GLA> __device__ __forceinline__ void rec_sample_item(const P& p, unsigned char* ws, int l, LAS unsigned char* lds, int b, int head) {
    constexpr int nheads = GLA ? GH : HH, ldk = GLA ? GKW : HW, NV4 = V / 4, NCG = NTHR / NV4, CPG = 128 / NCG;
    const int tid = tidx(); const size_t row = (size_t)(MP + b);
    LAS float* DQ = (LAS float*)lds; LAS float* RED = (LAS float*)(lds + 2048);
    __syncthreads();
    if (tid < 128) {
        DQ[tid] = __expf(((const float*)(ws + (GLA ? WS_LOGA : WS_LOGF)))[row * ldk + head * 128 + tid]);
        DQ[128 + tid] = bf2f(((const bf16_t*)(ws + (GLA ? WS_KG : WS_KH)))[row * ldk + head * 128 + tid]);
        DQ[256 + tid] = bf2f(((const bf16_t*)(ws + (GLA ? WS_QG : WS_QH)))[row * ldk + head * 128 + tid]);
    }
    __syncthreads();
    const int v4 = tid % NV4, cg = tid / NV4;
    const u32x2 vw = *(const u32x2*)((const bf16_t*)(ws + (GLA ? WS_VG : WS_VH)) + row * 1024 + head * V + v4 * 4);
    const f32x4 vv = (f32x4){__uint_as_float(vw.x << 16), __uint_as_float(vw.x & 0xffff0000u), __uint_as_float(vw.y << 16), __uint_as_float(vw.y & 0xffff0000u)};
    const size_t sbase = ((size_t)l * DECB * nheads + (size_t)b * nheads + head) * 128 * V;
    const float* s0 = (GLA ? p.stg : p.sth) + sbase; float* so = p.out + (GLA ? OUT_GS : OUT_HS) + sbase;
    f32x4 oacc = (f32x4){0.f, 0.f, 0.f, 0.f};
    f32x4 sv[CPG];
#pragma unroll
    for (int i = 0; i < CPG; ++i) sv[i] = __builtin_nontemporal_load((const f32x4*)(s0 + (size_t)(cg * CPG + i) * V + v4 * 4));
#pragma unroll
    for (int i = 0; i < CPG; ++i) { const int cc = cg * CPG + i; const f32x4 sn = sv[i] * DQ[cc] + vv * DQ[128 + cc]; __builtin_nontemporal_store(sn, (f32x4*)(so + (size_t)cc * V + v4 * 4)); oacc += sn * DQ[256 + cc]; }
    *(LAS f32x4*)(RED + cg * V + v4 * 4) = oacc;
    __syncthreads();
    float s = 0.f;
    if (tid < V) {
#pragma unroll
        for (int g = 0; g < NCG; ++g) s += RED[g * V + tid]; }
    { float q = wave_sum(tid < V ? s * s : 0.f);
      __syncthreads();
      if ((tid & 63) == 0) DQ[384 + (tid >> 6)] = q;
      __syncthreads();
      float tot = 0.f;
#pragma unroll
      for (int k = 0; k < V / 64; ++k) tot += DQ[384 + k];
      if (tid < V) { const float rs = rsqrtf(tot * (1.f / V) + EPS);
          const float gn = (GLA ? p.gln + l * GV : p.hgn + l * HV)[tid];
          const float gt = bf2f(((const bf16_t*)(ws + (GLA ? WS_RG : WS_GHG)))[row * 1024 + head * V + tid]);
          ((bf16_t*)(ws + WS_OG))[row * D + (GLA ? 1024 : 0) + head * V + tid] = (bf16_t)pk2(s * rs * gn * gt, 0.f); } }
}
constexpr int REP_SST = 1, REP_LOOP = 1;
#ifndef LK_ITEMS
#define LK_ITEMS 0
#endif
__device__ __forceinline__ void phase_rec(const P& p, unsigned char* ws, int l, LAS unsigned char* lds, int wg, int nwg) {
    int lrank = wg, nloop = nwg, srank = wg, nstr = nwg;
    const bool split = nwg >= 16;
    if (split) { const int grp = wg >> 3, ngrp = (nwg + 7) >> 3, nlg = (ngrp + 1) >> 1;
        const int full_l = nlg * 8 - ((ngrp & 1) ? (ngrp * 8 - nwg) : 0), full_s = nwg - full_l;
        nloop = full_l; nstr = full_s; lrank = (grp >> 1) * 8 + (wg & 7); srank = (grp >> 1) * 8 + (wg & 7);
        if (grp & 1) lrank = 1 << 30; else srank = 1 << 30; }
    for (int rl = 0; rl < REP_LOOP; ++rl) for (int tk = lrank; tk < 128; tk += nloop) rec_loop_task(p, ws, l, lds, tk);
    const int nlk = split ? LK_ITEMS * nloop : 0;
    for (int rs = 0; rs < REP_SST; ++rs) {
    if (split) for (int it = lrank; it < nlk; it += nloop) rec_sample_item<HV, false>(p, ws, l, lds, it >> 3, it & 7);
    for (int it = nlk + srank; it < DECB * HH; it += nstr) rec_sample_item<HV, false>(p, ws, l, lds, it >> 3, it & 7);
    for (int it = srank; it < DECB * GH; it += nstr) rec_sample_item<GV, true>(p, ws, l, lds, it >> 2, it & 3); }
}


constexpr int SG32_LD = 36;
template <int MODE, int NST, class F>
__device__ __forceinline__ void sample_gemm32(const bf16_t* A, int lda, const bf16_t* Bt, int ldb, int N, const F& f, float* aux, LAS unsigned char* lds, int wg, int nwg) {
    const int tid = tidx(), lane = tid & 63, w = __builtin_amdgcn_readfirstlane(tid >> 6), fr = lane & 15, fq = lane >> 4;
    constexpr int Kw = NST * 32;
    const int nitems = (N / 32) * 4;
    LAS float* tile = (LAS float*)lds;
    for (int item = wg; item < nitems; item += nwg) {
        const int rb = item & 3, cb = item >> 2;
        const char* abase = (const char*)(A + (size_t)(rb * 32) * lda + w * Kw);
        const char* bbase = (const char*)(Bt + (size_t)(cb * 32) * ldb + w * Kw);
        unsigned aoff[2], boff[2];
#pragma unroll
        for (int t2 = 0; t2 < 2; ++t2) { aoff[t2] = (unsigned)((t2 * 16 + fr) * lda + fq * 8) * 2u; boff[t2] = (unsigned)((t2 * 16 + fr) * ldb + fq * 8) * 2u; }
        bf16x8_t av[NST][2], bv[NST][2];
#pragma unroll
        for (int st = 0; st < NST; ++st)
#pragma unroll
            for (int t2 = 0; t2 < 2; ++t2) { av[st][t2] = *(const bf16x8_t*)(abase + st * 64 + aoff[t2]); bv[st][t2] = *(const bf16x8_t*)(bbase + st * 64 + boff[t2]); }
        f32x4 acc[2][2];
#pragma unroll
        for (int mt = 0; mt < 2; ++mt)
#pragma unroll
            for (int nt = 0; nt < 2; ++nt) acc[mt][nt] = (f32x4){0.f, 0.f, 0.f, 0.f};
#pragma unroll
        for (int st = 0; st < NST; ++st)
#pragma unroll
            for (int mt = 0; mt < 2; ++mt)
#pragma unroll
                for (int nt = 0; nt < 2; ++nt) acc[mt][nt] = MFMA16(bv[st][nt], av[st][mt], acc[mt][nt]);
        __syncthreads();
        LAS float* tk = tile + w * (32 * SG32_LD);
#pragma unroll
        for (int mt = 0; mt < 2; ++mt)
#pragma unroll
            for (int nt = 0; nt < 2; ++nt) *(LAS f32x4*)(tk + (mt * 16 + fr) * SG32_LD + nt * 16 + fq * 4) = acc[mt][nt];
        __syncthreads();
        if (tid < 128) {
            const int r = tid >> 2, cq = (tid & 3) * 8;
            f32x4 x0 = *(const LAS f32x4*)(tile + r * SG32_LD + cq), x1 = *(const LAS f32x4*)(tile + r * SG32_LD + cq + 4);
#pragma unroll
            for (int q = 1; q < 8; ++q) { x0 += *(const LAS f32x4*)(tile + q * (32 * SG32_LD) + r * SG32_LD + cq); x1 += *(const LAS f32x4*)(tile + q * (32 * SG32_LD) + r * SG32_LD + cq + 4); }
            const float v[8] = {x0[0], x0[1], x0[2], x0[3], x1[0], x1[1], x1[2], x1[3]};
            const int row = MP + rb * 32 + r;
            if constexpr (MODE == 0) f.apply8(row, cb * 32 + cq, v, f.rowctx(row));
            else { float ssum = f.apply8s(row, cb * 32 + cq, v); ssum += __shfl_xor(ssum, 1); ssum += __shfl_xor(ssum, 2); if ((tid & 3) == 0) aux[(size_t)row * SSQW + cb] = ssum; }
        }
    }
    __syncthreads();
}

constexpr int SG64_LD = 68;
#ifndef SG64_SB
#define SG64_SB 2
#endif
static_assert(8 * 64 * SG64_LD * 4 <= LDS_BYTES - 2048, "sample GEMM (64x64) LDS tiles");
template <int MODE, int KSPLIT, class F>
__device__ __forceinline__ void sample_gemm64(const bf16_t* A, int lda, const bf16_t* Bt, int ldb, int N, int K, const F& f, float* aux, LAS unsigned char* lds, int wg, int nwg) {
    const int tid = tidx(), lane = tid & 63, w = __builtin_amdgcn_readfirstlane(tid >> 6), fr = lane & 15, fq = lane >> 4;
    const int Kc = K / KSPLIT, Kw = Kc / 8, nbatch = Kw / (32 * SG64_SB), nitems = 2 * (N / 64) * KSPLIT;
    LAS float* tile = (LAS float*)lds;
    for (int item = wg; item < nitems; item += nwg) {
        const int rb = item & 1, rest = item >> 1, ks = rest % KSPLIT, cb = rest / KSPLIT;
        const char* abase = (const char*)(A + (size_t)(rb * 64) * lda + ks * Kc + w * Kw);
        const char* bbase = (const char*)(Bt + (size_t)(cb * 64) * ldb + ks * Kc + w * Kw);
        unsigned aoff[4], boff[4];
#pragma unroll
        for (int t4 = 0; t4 < 4; ++t4) { aoff[t4] = (unsigned)((t4 * 16 + fr) * lda + fq * 8) * 2u; boff[t4] = (unsigned)((t4 * 16 + fr) * ldb + fq * 8) * 2u; }
        f32x4 acc[4][4];
#pragma unroll
        for (int mt = 0; mt < 4; ++mt)
#pragma unroll
            for (int nt = 0; nt < 4; ++nt) acc[mt][nt] = (f32x4){0.f, 0.f, 0.f, 0.f};
#pragma nounroll
        for (int b = 0; b < nbatch; ++b) {
            bf16x8_t av[SG64_SB][4], bv[SG64_SB][4];
            const char* ab_ = abase + b * (64 * SG64_SB); const char* bb_ = bbase + b * (64 * SG64_SB);
#pragma unroll
            for (int st = 0; st < SG64_SB; ++st)
#pragma unroll
                for (int t4 = 0; t4 < 4; ++t4) { av[st][t4] = *(const bf16x8_t*)(ab_ + st * 64 + aoff[t4]); bv[st][t4] = *(const bf16x8_t*)(bb_ + st * 64 + boff[t4]); }
#pragma unroll
            for (int st = 0; st < SG64_SB; ++st)
#pragma unroll
                for (int mt = 0; mt < 4; ++mt)
#pragma unroll
                    for (int nt = 0; nt < 4; ++nt) acc[mt][nt] = MFMA16(bv[st][nt], av[st][mt], acc[mt][nt]);
        }
        __syncthreads();
        LAS float* tk = tile + w * (64 * SG64_LD);
#pragma unroll
        for (int mt = 0; mt < 4; ++mt)
#pragma unroll
            for (int nt = 0; nt < 4; ++nt) *(LAS f32x4*)(tk + (mt * 16 + fr) * SG64_LD + nt * 16 + fq * 4) = acc[mt][nt];
        __syncthreads();
        const int r = tid >> 3, cq = (tid & 7) * 8;
        f32x4 x0 = *(const LAS f32x4*)(tile + r * SG64_LD + cq), x1 = *(const LAS f32x4*)(tile + r * SG64_LD + cq + 4);
#pragma unroll
        for (int q = 1; q < 8; ++q) { x0 += *(const LAS f32x4*)(tile + q * (64 * SG64_LD) + r * SG64_LD + cq); x1 += *(const LAS f32x4*)(tile + q * (64 * SG64_LD) + r * SG64_LD + cq + 4); }
        const float v[8] = {x0[0], x0[1], x0[2], x0[3], x1[0], x1[1], x1[2], x1[3]};
        const int row = MP + rb * 64 + r, col = cb * 64 + cq;
        if constexpr (MODE == 0) f.apply8(row, col, v, f.rowctx(row));
        else { float* dst = aux + ((size_t)ks * DECB + (row - MP)) * N + col; *(f32x4*)dst = x0; *(f32x4*)(dst + 4) = x1; }
    }
    __syncthreads();
}

#define XB_TMO      128
#define XB_XCNT(j)  (256  + 64 * (j))
#define XB_XSUB(j)  (1280 + 64 * (j))
#define XB_XGEN(j)  (2304 + 64 * (j))
#define XB_TOP      3328
#define XB_TOPGEN   3392
#define XCD_BAR_WORDS 3456
#define XB_SPIN_CAP (1u << 18)
__device__ __forceinline__ unsigned xb_ld(unsigned* p)              { return __hip_atomic_load(p, __ATOMIC_RELAXED, __HIP_MEMORY_SCOPE_AGENT); }
__device__ __forceinline__ unsigned xb_add(unsigned* p, unsigned v) { return __hip_atomic_fetch_add(p, v, __ATOMIC_RELAXED, __HIP_MEMORY_SCOPE_AGENT); }
__device__ __forceinline__ unsigned xb_xcc_id() { return (unsigned)__builtin_amdgcn_s_getreg((3 << 11) | 20) & 0xFu; }
#define XB_SPIN(cond, bar) do { unsigned _sp = 0; while (cond) { __builtin_amdgcn_s_sleep(1); \
    if ((++_sp & 255u) == 0u) { if (xb_ld(&(bar)[XB_TMO])) break; if (_sp > XB_SPIN_CAP) { atomicAdd(&(bar)[XB_TMO], 1u); break; } } } } while (0)
struct XcdBarrier { unsigned* bar; unsigned x; volatile LAS unsigned* st; };
__device__ __forceinline__ XcdBarrier xcd_barrier_post(unsigned* bar, volatile LAS unsigned* st) {
    XcdBarrier b; b.bar = bar; b.x = xb_xcc_id(); b.st = st;
    if (threadIdx.x == 0) (void)xb_add(&bar[XB_XCNT(b.x)], 1u);
    return b;
}
__device__ __forceinline__ void xcd_barrier_complete(unsigned* bar, unsigned x, unsigned& nloc, unsigned& nx) {
    const unsigned G = gridDim.x * gridDim.y * gridDim.z;
    unsigned sum, cnt, mine, sp = 0u;
    for (;;) {
        sum = 0u; cnt = 0u; mine = 0u;
#pragma unroll
        for (unsigned j = 0; j < 16; ++j) { const unsigned c = xb_ld(&bar[XB_XCNT(j)]); sum += c; cnt += (c > 0u) ? 1u : 0u; mine = (j == x) ? c : mine; }
        if (sum == G) break;
        __builtin_amdgcn_s_sleep(1);
        if ((++sp & 255u) == 0u) { if (xb_ld(&bar[XB_TMO])) break; if (sp > XB_SPIN_CAP) { atomicAdd(&bar[XB_TMO], 1u); break; } }
    }
    nloc = mine > 0u ? mine : 1u; nx = cnt > 0u ? cnt : 1u;
}
__device__ __forceinline__ void xcd_barrier(const XcdBarrier& b) {
    asm volatile("s_waitcnt vmcnt(0)" ::: "memory");
    __syncthreads();
    if (threadIdx.x == 0) {
        unsigned* bar = b.bar;
        __builtin_amdgcn_s_waitcnt(0);
        unsigned nloc = b.st[0], nx = b.st[1];
        if (nloc == 0u) { xcd_barrier_complete(bar, b.x, nloc, nx); b.st[0] = nloc; b.st[1] = nx; }
        const unsigned old = xb_add(&bar[XB_XSUB(b.x)], 1u);
        const unsigned gen = old / nloc;
        if (old + 1u == (gen + 1u) * nloc) {
            __builtin_amdgcn_fence(__ATOMIC_RELEASE, "agent");
            asm volatile("s_waitcnt vmcnt(0)" ::: "memory");
            const unsigned og = xb_add(&bar[XB_TOP], 1u);
            const unsigned tg = og / nx;
            if (og + 1u == (tg + 1u) * nx) xb_add(&bar[XB_TOPGEN], 1u);
            else XB_SPIN(xb_ld(&bar[XB_TOPGEN]) == tg, bar);
            __builtin_amdgcn_fence(__ATOMIC_ACQUIRE, "agent");
            xb_add(&bar[XB_XGEN(b.x)], 1u);
            asm volatile("s_waitcnt vmcnt(0)" ::: "memory");
        } else {
            XB_SPIN(xb_ld(&bar[XB_XGEN(b.x)]) == gen, bar);
            __builtin_amdgcn_fence(__ATOMIC_ACQUIRE, "agent");
            asm volatile("s_waitcnt vmcnt(0)" ::: "memory");
        }
    }
    __syncthreads();
}


constexpr int LDS_P_OFF = LDS_BYTES - 2048 + 256;
constexpr int RST_OFF = 131072;
static_assert(RST_OFF + 4 * 256 * 4 + 16 <= LDS_BYTES - 2048, "rstd table");
__device__ __forceinline__ const float* lds_ptr(LAS unsigned char* lds, int i) {
    const unsigned lo = *(LAS const unsigned*)(lds + LDS_P_OFF + 8 * i), hi = *(LAS const unsigned*)(lds + LDS_P_OFF + 8 * i + 4);
    return (const float*)(const __attribute__((address_space(1))) float*)(((unsigned long long)(unsigned)__builtin_amdgcn_readfirstlane((int)hi) << 32) | (unsigned)__builtin_amdgcn_readfirstlane((int)lo));
}
__device__ __forceinline__ P load_P(LAS unsigned char* lds) {
    P p;
    p.xp = lds_ptr(lds, 0); p.xs = lds_ptr(lds, 1); p.pp = lds_ptr(lds, 2); p.ps = lds_ptr(lds, 3); p.sth = lds_ptr(lds, 4); p.stg = lds_ptr(lds, 5);
    p.n_pre_mix = lds_ptr(lds, 6); p.n_post_mix = lds_ptr(lds, 7); p.n_pre_ffn = lds_ptr(lds, 8); p.n_post_ffn = lds_ptr(lds, 9); p.w_in = lds_ptr(lds, 10); p.lbp = lds_ptr(lds, 11);
    p.hgn = lds_ptr(lds, 12); p.w_hup = lds_ptr(lds, 13); p.wgg = lds_ptr(lds, 14); p.bgg = lds_ptr(lds, 15); p.gln = lds_ptr(lds, 16); p.w_gup = lds_ptr(lds, 17);
    p.w_out = lds_ptr(lds, 18); p.w_ff1 = lds_ptr(lds, 19); p.w_ff2 = lds_ptr(lds, 20); p.w_ple = lds_ptr(lds, 21); p.w_plg = lds_ptr(lds, 22);
    p.out = (float*)lds_ptr(lds, 23); p.ws = (unsigned char*)lds_ptr(lds, 24);
    return p;
}

constexpr int LDSCTL_OFF = LDS_BYTES - 2048;
constexpr int CW_BAR = 1024;
static_assert(CW_TMO == CW_BAR + XB_TMO, "timeout word index");
constexpr int REP_PRO = 1, REP_GEMM = 1, REP_REC = 1, REP_ONORM = 1, REP_BAR = 1, REP_GS = 1, REP_POST = 1, REP_P7 = 1, REP_PREP = 1;
constexpr int REP_G[8] = {1, 1, 1, 1, 1, 1, 1, 1};
struct Args { P p; int ph_lo, ph_hi; };
__global__ void __launch_bounds__(NTHR, 2) mega(const Args a) {
    extern __shared__ __attribute__((aligned(16))) unsigned char lds_raw[];
    LAS unsigned char* lds = (LAS unsigned char*)lds_raw;
    const int wg0 = blockIdx.x, nwg0 = gridDim.x, tid = threadIdx.x;
    for (int u = tid; u < (LDS_BYTES - LDSCTL_OFF) / 4; u += NTHR) ((LAS unsigned*)(lds + LDSCTL_OFF))[u] = 0u;
    __syncthreads();
    if (tid == 0) { const unsigned long long* src = (const unsigned long long*)&a.p;
#pragma unroll
        for (int i = 0; i < 25; ++i) *(LAS unsigned long long*)(lds + LDS_P_OFF + 8 * i) = src[i]; }
    __syncthreads();
    unsigned char* const ws0 = (unsigned char*)lds_ptr(lds, 24);
    XcdBarrier bar = xcd_barrier_post((unsigned*)(ws0 + WS_CTL) + CW_BAR, (volatile LAS unsigned*)(lds + LDSCTL_OFF + 32));
    const int lo = a.ph_lo, hi = a.ph_hi; int ph = 0;
#define PH_BEGIN if (ph >= lo && ph < hi) { unsigned long long wsi_ = (unsigned long long)ws0; int l = l0, wg = wg0, nwg = nwg0; asm volatile("" : "+s"(wsi_), "+s"(l), "+s"(wg), "+s"(nwg) :: "memory"); unsigned char* ws = (unsigned char*)(__attribute__((address_space(1))) unsigned char*)wsi_; const P p = load_P(lds); const int gtid = wg * NTHR + tidx(), gthreads = nwg * NTHR; (void)gtid; (void)gthreads;
#define PH_END } if (ph >= lo && ph + 1 < hi) for (int rb = 0; rb < REP_BAR; ++rb) xcd_barrier(bar); ++ph;
#define PH_END_NOBAR } ++ph;

    int l0 = 0;
    PH_BEGIN (void)l; for (int rep = 0; rep < REP_PRO; ++rep) phase_prologue(p, ws, lds, wg, nwg); PH_END
    PH_BEGIN (void)l;
    { int Kp = PLE; asm volatile("" : "+s"(Kp));
      pg8::Gemm g{(const bf16_t*)(ws + WS_PBF), (const bf16_t*)(ws + WS_WPLE), DEPTH * MP, DEPTH * D, Kp, PLE, PLE}; DiagOrder S{nwg, wg};
      EpiA<FPeD> E{FPeD{(bf16_t*)(ws + WS_PE)}};
      for (int rgp = 0; rgp < REP_G[0]; ++rgp) pg8::gemm_phase<EpiA<FPeD>, DiagOrder, true, true>(lds, g, S, E); }
    for (int l = 0; l < DEPTH; ++l) {
        FPe f{(bf16_t*)(ws + WS_PE) + (size_t)l * MR * D};
        sample_gemm32<0, PLE / 256>((const bf16_t*)(ws + WS_PBF) + (size_t)DEPTH * MP * PLE + (size_t)l * DECB * PLE, PLE, (const bf16_t*)(ws + WS_WPLE) + (size_t)l * D * PLE, PLE, D, f, (float*)nullptr, lds, wg, nwg);
    }
    PH_END_NOBAR
    for (l0 = 0; l0 < DEPTH; ++l0) {
#define HBF_CUR ((bf16_t*)(ws + ((l & 1) ? WS_HBF2 : WS_HBF)))
#define HBF_NXT ((bf16_t*)(ws + ((l & 1) ? WS_HBF : WS_HBF2)))
        PH_BEGIN
        for (int rep = 0; rep < REP_GEMM; ++rep) {
        const bf16_t* A = HBF_CUR; const bf16_t* Wt = (const bf16_t*)(ws + WS_WIN) + (size_t)l * NZ * D;
        pg8::Gemm g{A, Wt, MR, NZ, D, D, D}; pg8::StaticOrder S; S.init(MR, NZ, nwg, wg);
        FIn f{(const float*)(ws + WS_SSQ), (const float*)(ws + WS_LBS) + l * HW, p.bgg + l * GKW, ws, (const LAS float*)(lds + RST_OFF), -1, -1, -1};
        {
            { pg8::Unit u_;
#pragma nounroll
              for (int i = 0; S.next(i, u_); ++i) { if (u_.pm == f.pm0 || u_.pm == f.pm1 || u_.pm == f.pm2) continue; if (f.pm0 < 0) f.pm0 = u_.pm; else if (f.pm1 < 0) f.pm1 = u_.pm; else if (f.pm2 < 0) f.pm2 = u_.pm; } }
            const int t_ = tidx(); LAS float* tb = (LAS float*)(lds + RST_OFF);
            if (t_ < 256) { if (f.pm0 >= 0) tb[t_] = f.rowctx_g(f.pm0 * 256 + t_); if (f.pm1 >= 0) tb[256 + t_] = f.rowctx_g(f.pm1 * 256 + t_); if (f.pm2 >= 0) tb[512 + t_] = f.rowctx_g(f.pm2 * 256 + t_); }
            __syncthreads(); }
        EpiA<FIn> E{f};
        for (int rgp = 0; rgp < REP_G[1]; ++rgp) pg8::gemm_phase<EpiA<FIn>, pg8::StaticOrder, true, true>(lds, g, S, E);
        }
        PH_END
        PH_BEGIN for (int rep = 0; rep < REP_PREP; ++rep) { for (int tkp = wg; tkp < NSH * 32; tkp += nwg) rec_prep_task(ws, lds, tkp); __syncthreads(); } PH_END
        PH_BEGIN for (int rep = 0; rep < REP_REC; ++rep) phase_rec(p, ws, l, lds, wg, nwg); PH_END
        PH_BEGIN
        for (int rep = 0; rep < REP_GEMM; ++rep) {
        { const bf16_t* A = (const bf16_t*)(ws + WS_OG); const bf16_t* Wt = (const bf16_t*)(ws + WS_WUH) + (size_t)l * D * HW;
          pg8::Gemm g{A, Wt, MP, D, HW, D, HW}; pg8::StaticOrder S; S.init(MP, D, nwg, wg);
          EpiAP<FUp1> E{FUp1{(const bf16_t*)(ws + WS_MH), (bf16_t*)(ws + WS_T4)}};
          for (int rgp = 0; rgp < REP_G[2]; ++rgp) pg8::gemm_phase<EpiAP<FUp1>, pg8::StaticOrder, true, true>(lds, g, S, E);
          for (int rgs = 0; rgs < REP_GS; ++rgs) sample_gemm32<0, HW / 256>(A + (size_t)MP * D, D, Wt, HW, D, E.f, (float*)nullptr, lds, wg, nwg); }
        asm volatile("s_waitcnt vmcnt(0)" ::: "memory");
        { const bf16_t* A = (const bf16_t*)(ws + WS_OG) + 1024; const bf16_t* Wt = (const bf16_t*)(ws + WS_WUG) + (size_t)l * D * GVW;
          pg8::Gemm g{A, Wt, MP, D, GVW, D, GVW}; pg8::StaticOrder S; S.init(MP, D, nwg, wg);
          EpiAP<FUp2> E{FUp2{(const bf16_t*)(ws + WS_MG), (const bf16_t*)(ws + WS_T4), (bf16_t*)(ws + WS_MRG)}};
          for (int rgp = 0; rgp < REP_G[3]; ++rgp) pg8::gemm_phase<EpiAP<FUp2>, pg8::StaticOrder, true, true>(lds, g, S, E);
          for (int rgs = 0; rgs < REP_GS; ++rgs) sample_gemm32<0, GVW / 256>(A + (size_t)MP * D, D, Wt, GVW, D, E.f, (float*)nullptr, lds, wg, nwg); }
        }
        PH_END
        PH_BEGIN
        for (int rep = 0; rep < REP_GEMM; ++rep)
        { const bf16_t* A = (const bf16_t*)(ws + WS_MRG); const bf16_t* Wt = (const bf16_t*)(ws + WS_WOUT) + (size_t)l * D * D;
          pg8::Gemm g{A, Wt, MP, D, D, D, D}; pg8::StaticOrder S; S.init(MP, D, nwg, wg);
          EpiPost4 E{HBF_CUR, p.n_post_mix + l * D, (bf16_t*)(ws + WS_T4), (float*)(ws + WS_CTL) + CW_SSQ2, (float*)(ws + WS_CTL) + CW_X4, (unsigned*)(ws + WS_CTL) + CW_X4CNT + l * 32 * 64, (unsigned*)(ws + WS_CTL) + CW_BAR + XB_TMO};
          pg8::gemm_phase<EpiPost4, pg8::StaticOrder, true, true>(lds, g, S, E);
          for (int rgs = 0; rgs < REP_GS; ++rgs) sample_gemm32<0, D / 256>(A + (size_t)MP * D, D, Wt, D, D, FPartS{(float*)(ws + WS_PART4)}, (float*)nullptr, lds, wg, nwg); }
        PH_END
        PH_BEGIN for (int rep = 0; rep < REP_POST; ++rep) thin_post<0>(ws, lds, HBF_CUR, p.n_post_mix + l * D, p.n_pre_ffn + l * D, nullptr, nullptr, wg, nwg); PH_END
        PH_BEGIN
        for (int rep = 0; rep < REP_GEMM; ++rep)
        { const bf16_t* A = (const bf16_t*)(ws + WS_T4); const bf16_t* Wt = (const bf16_t*)(ws + WS_WFF1) + (size_t)l * DFF * D;
          pg8::Gemm g{A, Wt, MP, DFF, D, D, D}; pg8::StaticOrder S; S.init(MP, DFF, nwg, wg);
          FRelu2 f{(bf16_t*)(ws + WS_U), (const float*)(ws + WS_CTL) + CW_SSQ2, (const LAS float*)(lds + RST_OFF), -1, -1, -1, -1};
          { { pg8::Unit u_;
#pragma nounroll
              for (int i = 0; S.next(i, u_); ++i) { if (u_.pm == f.pm0 || u_.pm == f.pm1 || u_.pm == f.pm2 || u_.pm == f.pm3) continue; if (f.pm0 < 0) f.pm0 = u_.pm; else if (f.pm1 < 0) f.pm1 = u_.pm; else if (f.pm2 < 0) f.pm2 = u_.pm; else if (f.pm3 < 0) f.pm3 = u_.pm; } }
            const int t_ = tidx(); LAS float* tb = (LAS float*)(lds + RST_OFF);
            if (t_ < 256) { if (f.pm0 >= 0) tb[t_] = f.rowctx_g(f.pm0 * 256 + t_); if (f.pm1 >= 0) tb[256 + t_] = f.rowctx_g(f.pm1 * 256 + t_); if (f.pm2 >= 0) tb[512 + t_] = f.rowctx_g(f.pm2 * 256 + t_); if (f.pm3 >= 0) tb[768 + t_] = f.rowctx_g(f.pm3 * 256 + t_); }
            __syncthreads(); }
          EpiA<FRelu2> E{f};
          for (int rgp = 0; rgp < REP_G[5]; ++rgp) pg8::gemm_phase<EpiA<FRelu2>, pg8::StaticOrder, true, true>(lds, g, S, E);
          for (int rgs = 0; rgs < REP_GS; ++rgs) sample_gemm64<0, 1>(A + (size_t)MP * D, D, Wt, D, DFF, D, E.f, (float*)nullptr, lds, wg, nwg); }
        PH_END
        PH_BEGIN
        for (int rep = 0; rep < REP_GEMM; ++rep)
        { const bf16_t* A = (const bf16_t*)(ws + WS_U); const bf16_t* Wt = (const bf16_t*)(ws + WS_WFF2) + (size_t)l * D * DFF;
          pg8::Gemm g{A, Wt, MP, D, DFF, DFF, DFF}; pg8::StaticOrder S; S.init(MP, D, nwg, wg);
          EpiPost6 E{(const bf16_t*)(ws + WS_T4), p.n_post_ffn + l * D, (bf16_t*)(ws + WS_HBF3),
                     (float*)(ws + WS_CTL) + CW_X6, (unsigned*)(ws + WS_CTL) + CW_X6CNT + l * 32 * 64, (unsigned*)(ws + WS_CTL) + CW_BAR + XB_TMO};
          pg8::gemm_phase<EpiPost6, pg8::StaticOrder, true, true>(lds, g, S, E);
          for (int rgs = 0; rgs < REP_GS; ++rgs) sample_gemm64<2, 4>(A + (size_t)MP * DFF, DFF, Wt, DFF, D, DFF, FStoreBf{nullptr}, (float*)(ws + WS_PART6), lds, wg, nwg); }
        PH_END
        PH_BEGIN for (int rep = 0; rep < REP_POST; ++rep) thin_post<1>(ws, lds, HBF_CUR, p.n_post_mix + l * D, nullptr, p.n_post_ffn + l * D, (bf16_t*)(ws + WS_HBF3), wg, nwg); PH_END
        PH_BEGIN
        for (int rep = 0; rep < REP_P7; ++rep)
        { const bf16_t* A = (const bf16_t*)(ws + WS_HBF3); const bf16_t* Wt = (const bf16_t*)(ws + WS_WPLG) + (size_t)l * D * D;
          pg8::Gemm g{A, Wt, MP, D, D, D, D}; pg8::StaticOrder S; S.init(MP, D, nwg, wg);
          EpiPle E{FPle{(const bf16_t*)(ws + WS_HBF3), l == DEPTH - 1 ? p.out : (float*)nullptr, HBF_NXT, (const bf16_t*)(ws + WS_PE) + (size_t)l * MR * D}, (float*)(ws + WS_SSQ)};
          pg8::gemm_phase<EpiPle, pg8::StaticOrder, true, true>(lds, g, S, E);
          sample_gemm32<1, D / 256>(A + (size_t)MP * D, D, Wt, D, D, E.f, (float*)(ws + WS_SSQ), lds, wg, nwg); }
        PH_END
    }
#undef PH_BEGIN
#undef PH_END
#undef PH_END_NOBAR
}

#ifndef MK_PER_PHASE
#define MK_PER_PHASE 0
#endif
extern "C" void kernel_launch(void* const* d_in, const int* in_sizes, int n_in, void* d_out, int out_size, void* d_ws, size_t ws_size, hipStream_t stream) {
    static int grid = 0;
    if (grid == 0) {
        if (n_in != 23 || ws_size < WS_END) { fprintf(stderr, "kernel_launch: need 23 inputs and %zu bytes of workspace; got %d inputs, %zu bytes\n", (size_t)WS_END, n_in, ws_size); grid = -1; return; }
        int dev = 0, cus = 0, per_cu = 0;
        if (hipGetDevice(&dev) != hipSuccess || hipDeviceGetAttribute(&cus, hipDeviceAttributeMultiprocessorCount, dev) != hipSuccess) { fprintf(stderr, "kernel_launch: device query failed\n"); grid = -1; return; }
        if (hipFuncSetAttribute((const void*)mega, hipFuncAttributeMaxDynamicSharedMemorySize, LDS_BYTES) != hipSuccess) { fprintf(stderr, "kernel_launch: hipFuncSetAttribute failed\n"); grid = -1; return; }
        if (hipOccupancyMaxActiveBlocksPerMultiprocessor(&per_cu, (const void*)mega, NTHR, LDS_BYTES) != hipSuccess || per_cu < 1) { fprintf(stderr, "kernel_launch: occupancy query reports %d blocks per CU\n", per_cu); (void)hipGetLastError(); per_cu = 1; }
        grid = cus;
    }
    if (grid < 0) return;
    (void)hipMemsetAsync((char*)d_ws + WS_CTL, 0, CTL_BYTES, stream);
    Args a{};
    const float** pf = (const float**)&a.p;
    for (int i = 0; i < 23; ++i) pf[i] = (const float*)d_in[i];
    a.p.out = (float*)d_out; a.p.ws = (unsigned char*)d_ws;
    constexpr int NPH = 2 + DEPTH * 10;
#if MK_PER_PHASE
    for (int k = 0; k < NPH; ++k) { a.ph_lo = k; a.ph_hi = k + 1; hipLaunchKernelGGL(mega, dim3(grid), dim3(NTHR), LDS_BYTES, stream, a); }
#else
    a.ph_lo = 0; a.ph_hi = NPH;
    hipLaunchKernelGGL(mega, dim3(grid), dim3(NTHR), LDS_BYTES, stream, a);
#endif
}
```
